# Optimizing an MI355X kernel written in HIP

```python
import jax
import jax.numpy as jnp
from jax import lax
import numpy as np

D_MODEL = 1024
BATCH = 4
SEQ = 8192
DEPTH = 2

MLSTM_HEADS = 4
MLSTM_DQK = 64
MLSTM_DV = 128
MLSTM_CHUNK = 64
CONV_WIDTH = 4
MOBA_HEADS = 4
MOBA_DH = 64
MOBA_BLOCK = 256
MOBA_TOPK = 3
MOBA_Q_BLOCK = 64
ROPE_THETA = 500000.0
PARTIAL_ROPE_DIM = MOBA_DH // 4
MLA_HEADS = 4
MLA_NOPE = 64
MLA_ROPE = 32
MLA_DV = 64
MLA_Q_LORA = 384
MLA_KV_LORA = 256
MLA_ROPE_THETA = 10000.0
ATTN_Q_BLOCK = 128
D_FF = 4 * D_MODEL
NORM_EPS = 1e-6

MLSTM_WIDTH = MLSTM_HEADS * MLSTM_DV
MOBA_WIDTH = MOBA_HEADS * MOBA_DH
MLA_WIDTH = MLA_HEADS * MLA_DV
MIX_WIDTH = MLSTM_WIDTH + MOBA_WIDTH + MLA_WIDTH
MLA_QK_DIM = MLA_NOPE + MLA_ROPE
IN_SPLITS = (
    2 * MLSTM_HEADS * MLSTM_DQK,
    MLSTM_WIDTH,
    MLSTM_WIDTH,
    MLSTM_HEADS,
    MLSTM_HEADS,
    3 * MOBA_WIDTH,
    MLA_Q_LORA,
    MLA_KV_LORA,
    MLA_ROPE,
)
D_IN = sum(IN_SPLITS)

kernel_name = 'hybrid_mlstm_moba_mla_block'


def rms_norm(x, g):
    xf = x.astype(jnp.float32)
    y = xf * lax.rsqrt(jnp.mean(xf * xf, axis=-1, keepdims=True) + NORM_EPS)
    return (y * g.astype(jnp.float32)).astype(x.dtype)


def rope_tables(positions, dim, theta):
    inv_freq = jnp.power(jnp.float32(theta), -jnp.arange(0, dim, 2, dtype=jnp.float32) / dim)
    ang = positions.astype(jnp.float32)[..., None] * inv_freq
    return jnp.cos(ang), jnp.sin(ang)


def rotate(x, cos, sin):
    half = x.shape[-1] // 2
    x1 = x[..., :half].astype(jnp.float32)
    x2 = x[..., half:].astype(jnp.float32)
    c = cos[:, :, None, :]
    s = sin[:, :, None, :]
    return jnp.concatenate([x1 * c - x2 * s, x2 * c + x1 * s], axis=-1).astype(x.dtype)


def causal_depthwise_conv(x, w, b):
    C = x.shape[-1]
    y = lax.conv_general_dilated(
        x, w[:, None, :].astype(x.dtype), window_strides=(1,),
        padding=[(CONV_WIDTH - 1, 0)], dimension_numbers=('NWC', 'WIO', 'NWC'),
        feature_group_count=C)
    return y + b.astype(x.dtype)


def mlstm_chunkwise(q, k, v, i_pre, f_pre):
    B, S, H, DK = q.shape
    DV = v.shape[-1]
    L = MLSTM_CHUNK
    NC = S // L
    f32 = jnp.float32
    q = q.astype(f32) * (DK ** -0.5)
    k = k.astype(f32)
    v = v.astype(f32)
    log_f = jax.nn.log_sigmoid(f_pre.astype(f32))
    log_i = i_pre.astype(f32)

    def chunks(t):
        return t.reshape((B, NC, L) + t.shape[2:]).swapaxes(0, 1)

    causal = jnp.tril(jnp.ones((L, L), dtype=bool))

    def step(carry, inp):
        C, n, m = carry
        qj, kj, vj, lfj, lij = inp
        bt = jnp.cumsum(lfj, axis=1).transpose(0, 2, 1)
        it = lij.transpose(0, 2, 1)
        log_d = bt[:, :, :, None] - bt[:, :, None, :] + it[:, :, None, :]
        log_d = jnp.where(causal, log_d, -jnp.inf)
        log_inter = bt + m[:, :, None]
        m_t = jnp.maximum(log_inter, jnp.max(log_d, axis=-1))
        d = jnp.exp(log_d - m_t[..., None])
        inter = jnp.exp(log_inter - m_t)
        s = jnp.einsum('blhd,bshd->bhls', qj, kj) * d
        num = (jnp.einsum('bhls,bshv->bhlv', s, vj)
               + inter[..., None] * jnp.einsum('blhd,bhvd->bhlv', qj, C))
        den = jnp.sum(s, axis=-1) + inter * jnp.einsum('blhd,bhd->bhl', qj, n)
        h = num / jnp.maximum(jnp.abs(den), jnp.exp(-m_t))[..., None]
        b_last = bt[:, :, -1]
        log_w = b_last[:, :, None] - bt + it
        m_new = jnp.maximum(b_last + m, jnp.max(log_w, axis=-1))
        w = jnp.exp(log_w - m_new[..., None])
        decay = jnp.exp(b_last + m - m_new)
        C_new = decay[..., None, None] * C + jnp.einsum('bhs,bshv,bshd->bhvd', w, vj, kj)
        n_new = decay[..., None] * n + jnp.einsum('bhs,bshd->bhd', w, kj)
        return (C_new, n_new, m_new), h.transpose(0, 2, 1, 3)

    init = (jnp.zeros((B, H, DV, DK), f32), jnp.zeros((B, H, DK), f32), jnp.zeros((B, H), f32))
    _, h = lax.scan(step, init, (chunks(q), chunks(k), chunks(v), chunks(log_f), chunks(log_i)))
    return h.swapaxes(0, 1).reshape(B, S, H, DV)


def moba_attention(q, k, v):
    B, S, H, D = q.shape
    BS = MOBA_BLOCK
    QB = MOBA_Q_BLOCK
    NB = -(-S // BS)
    S_pad = NB * BS
    K = min(MOBA_TOPK, NB)
    scale = D ** -0.5
    qh = q.transpose(0, 2, 1, 3)
    pad = ((0, 0), (0, 0), (0, S_pad - S), (0, 0))
    kb = jnp.pad(k.transpose(0, 2, 1, 3), pad).reshape(B, H, NB, BS, D)
    vb = jnp.pad(v.transpose(0, 2, 1, 3), pad).reshape(B, H, NB, BS, D)
    k_mean = jnp.mean(kb.astype(jnp.float32), axis=3)
    b_idx = jnp.arange(B)[:, None, None, None]
    h_idx = jnp.arange(H)[None, :, None, None]

    def one_block(qi):
        start = qi * QB
        q_blk = lax.dynamic_slice_in_dim(qh, start, QB, axis=2)
        own = start // BS
        gate = jnp.einsum('bhqd,bhnd->bhqn', q_blk.astype(jnp.float32), k_mean)
        gate = jnp.where(jnp.arange(NB) < own, gate, -jnp.inf)
        _, sel = lax.top_k(gate, K)
        sel_valid = jnp.arange(K) < own
        k_sel = kb[b_idx, h_idx, sel]
        v_sel = vb[b_idx, h_idx, sel]
        s_sel = jnp.einsum('bhqd,bhqkjd->bhqkj', q_blk, k_sel).astype(jnp.float32) * scale
        s_sel = jnp.where(sel_valid[:, None], s_sel, -jnp.inf)
        k_own = lax.dynamic_index_in_dim(kb, own, axis=2, keepdims=False)
        v_own = lax.dynamic_index_in_dim(vb, own, axis=2, keepdims=False)
        s_own = jnp.einsum('bhqd,bhjd->bhqj', q_blk, k_own).astype(jnp.float32) * scale
        q_pos = start + jnp.arange(QB)
        k_pos = own * BS + jnp.arange(BS)
        s_own = jnp.where(k_pos[None, :] <= q_pos[:, None], s_own, -jnp.inf)
        s = jnp.concatenate([s_sel.reshape(B, H, QB, K * BS), s_own], axis=-1)
        p = jax.nn.softmax(s, axis=-1).astype(v.dtype)
        p_sel = p[..., :K * BS].reshape(B, H, QB, K, BS)
        p_own = p[..., K * BS:]
        return (jnp.einsum('bhqkj,bhqkjd->bhqd', p_sel, v_sel)
                + jnp.einsum('bhqj,bhjd->bhqd', p_own, v_own))

    out = lax.map(one_block, jnp.arange(S // QB))
    return out.transpose(1, 0, 3, 2, 4).reshape(B, S, H, D)


def causal_block_attention(q, k, v):
    B, S, H, Dk = q.shape
    Dv = v.shape[-1]
    QB = ATTN_Q_BLOCK
    scale = Dk ** -0.5
    qh = q.transpose(0, 2, 1, 3)
    kh = k.transpose(0, 2, 1, 3)
    vh = v.transpose(0, 2, 1, 3)
    k_pos = jnp.arange(S)

    def one_block(qi):
        start = qi * QB
        q_blk = lax.dynamic_slice_in_dim(qh, start, QB, axis=2)
        s = jnp.einsum('bhqd,bhkd->bhqk', q_blk, kh).astype(jnp.float32) * scale
        q_pos = start + jnp.arange(QB)
        s = jnp.where(k_pos[None, :] <= q_pos[:, None], s, -jnp.inf)
        p = jax.nn.softmax(s, axis=-1).astype(vh.dtype)
        return jnp.einsum('bhqk,bhkd->bhqd', p, vh)

    out = lax.map(one_block, jnp.arange(S // QB))
    return out.transpose(1, 0, 3, 2, 4).reshape(B, S, H, Dv)


def hybrid_layer(x, cos_p, sin_p, cos_d, sin_d, w_in, conv_w, conv_b, b_igate, b_fgate,
                 g_mix_norm, g_mlstm_out, g_moba_q, g_moba_k, g_moba_out, g_cq, g_ckv,
                 w_uq, w_ukv, g_mla_q, g_mla_k, g_mla_out, w_out, g_mlp_norm, w_up, w_down):
    B, S, _ = x.shape
    h = rms_norm(x, g_mix_norm)
    proj = h @ w_in
    offsets = [int(o) for o in np.cumsum(IN_SPLITS)[:-1]]
    m_qk, m_v, m_o, m_i, m_f, moba_qkv, cq, ckv, kpe = jnp.split(proj, offsets, axis=-1)

    qk = jax.nn.silu(causal_depthwise_conv(m_qk, conv_w, conv_b))
    mq, mk = jnp.split(qk, 2, axis=-1)
    mq = mq.reshape(B, S, MLSTM_HEADS, MLSTM_DQK)
    mk = mk.reshape(B, S, MLSTM_HEADS, MLSTM_DQK)
    mv = m_v.reshape(B, S, MLSTM_HEADS, MLSTM_DV)
    hm = mlstm_chunkwise(mq, mk, mv, m_i + b_igate, m_f + b_fgate).astype(x.dtype)
    hm = rms_norm(hm, g_mlstm_out) * jax.nn.sigmoid(m_o).reshape(B, S, MLSTM_HEADS, MLSTM_DV)

    aq, ak, av = jnp.split(moba_qkv.reshape(B, S, 3 * MOBA_HEADS, MOBA_DH), 3, axis=2)
    aq = rms_norm(aq, g_moba_q)
    ak = rms_norm(ak, g_moba_k)
    aq = jnp.concatenate([rotate(aq[..., :PARTIAL_ROPE_DIM], cos_p, sin_p), aq[..., PARTIAL_ROPE_DIM:]], axis=-1)
    ak = jnp.concatenate([rotate(ak[..., :PARTIAL_ROPE_DIM], cos_p, sin_p), ak[..., PARTIAL_ROPE_DIM:]], axis=-1)
    ha = rms_norm(moba_attention(aq, ak, av), g_moba_out)

    lq = (rms_norm(cq, g_cq) @ w_uq).reshape(B, S, MLA_HEADS, MLA_QK_DIM)
    kv = (rms_norm(ckv, g_ckv) @ w_ukv).reshape(B, S, MLA_HEADS, MLA_NOPE + MLA_DV)
    lk = jnp.concatenate(
        [kv[..., :MLA_NOPE], jnp.broadcast_to(kpe[:, :, None, :], (B, S, MLA_HEADS, MLA_ROPE))], axis=-1)
    lv = kv[..., MLA_NOPE:]
    lq = rms_norm(lq, g_mla_q)
    lk = rms_norm(lk, g_mla_k)
    lq = jnp.concatenate([lq[..., :MLA_NOPE], rotate(lq[..., MLA_NOPE:], cos_d, sin_d)], axis=-1)
    lk = jnp.concatenate([lk[..., :MLA_NOPE], rotate(lk[..., MLA_NOPE:], cos_d, sin_d)], axis=-1)
    hl = rms_norm(causal_block_attention(lq, lk, lv), g_mla_out)

    mix = jnp.concatenate([hm.reshape(B, S, MLSTM_WIDTH), ha.reshape(B, S, MOBA_WIDTH),
                           hl.reshape(B, S, MLA_WIDTH)], axis=-1)
    x = x + mix @ w_out

    h2 = rms_norm(x, g_mlp_norm)
    x = x + jnp.square(jax.nn.relu(h2 @ w_up)) @ w_down
    return x


def setup_inputs(seed: int = 0) -> dict:
    key = jax.random.key(seed)
    ks = jax.random.split(key, 24)
    f32 = jnp.float32

    def nrm(k, shape, scale):
        return jax.random.normal(k, shape, f32) * scale

    def gain(k, shape):
        return 1.0 + 0.02 * jax.random.normal(k, shape, f32)

    Ld = DEPTH
    x = nrm(ks[0], (BATCH, SEQ, D_MODEL), 1.0)
    offset = jax.random.randint(ks[1], (BATCH, 1), 0, 4096, dtype=jnp.int32)
    positions = offset + jnp.arange(SEQ, dtype=jnp.int32)[None, :]
    return {
        'x': x,
        'positions': positions,
        'w_in': nrm(ks[2], (Ld, D_MODEL, D_IN), D_MODEL ** -0.5),
        'conv_w': nrm(ks[3], (Ld, CONV_WIDTH, 2 * MLSTM_HEADS * MLSTM_DQK), 0.5),
        'conv_b': nrm(ks[4], (Ld, 2 * MLSTM_HEADS * MLSTM_DQK), 0.01),
        'b_igate': nrm(ks[5], (Ld, MLSTM_HEADS), 0.1),
        'b_fgate': 3.0 + nrm(ks[6], (Ld, MLSTM_HEADS), 0.5),
        'g_mix_norm': gain(ks[7], (Ld, D_MODEL)),
        'g_mlstm_out': gain(ks[8], (Ld, MLSTM_HEADS, MLSTM_DV)),
        'g_moba_q': gain(ks[9], (Ld, MOBA_DH)),
        'g_moba_k': gain(ks[10], (Ld, MOBA_DH)),
        'g_moba_out': gain(ks[11], (Ld, MOBA_HEADS, MOBA_DH)),
        'g_cq': gain(ks[12], (Ld, MLA_Q_LORA)),
        'g_ckv': gain(ks[13], (Ld, MLA_KV_LORA)),
        'w_uq': nrm(ks[14], (Ld, MLA_Q_LORA, MLA_HEADS * MLA_QK_DIM), MLA_Q_LORA ** -0.5),
        'w_ukv': nrm(ks[15], (Ld, MLA_KV_LORA, MLA_HEADS * (MLA_NOPE + MLA_DV)), MLA_KV_LORA ** -0.5),
        'g_mla_q': gain(ks[16], (Ld, MLA_QK_DIM)),
        'g_mla_k': gain(ks[17], (Ld, MLA_QK_DIM)),
        'g_mla_out': gain(ks[18], (Ld, MLA_HEADS, MLA_DV)),
        'w_out': nrm(ks[19], (Ld, MIX_WIDTH, D_MODEL), 0.5 * MIX_WIDTH ** -0.5),
        'g_mlp_norm': gain(ks[20], (Ld, D_MODEL)),
        'w_up': nrm(ks[21], (Ld, D_MODEL, D_FF), D_MODEL ** -0.5),
        'w_down': nrm(ks[22], (Ld, D_FF, D_MODEL), 0.5 * D_FF ** -0.5),
    }


def reference(x, positions, w_in, conv_w, conv_b, b_igate, b_fgate, g_mix_norm, g_mlstm_out,
              g_moba_q, g_moba_k, g_moba_out, g_cq, g_ckv, w_uq, w_ukv, g_mla_q, g_mla_k,
              g_mla_out, w_out, g_mlp_norm, w_up, w_down):
    cos_p, sin_p = rope_tables(positions, PARTIAL_ROPE_DIM, ROPE_THETA)
    cos_d, sin_d = rope_tables(positions, MLA_ROPE, MLA_ROPE_THETA)
    for l in range(DEPTH):
        x = hybrid_layer(
            x, cos_p, sin_p, cos_d, sin_d, w_in[l], conv_w[l], conv_b[l], b_igate[l], b_fgate[l],
            g_mix_norm[l], g_mlstm_out[l], g_moba_q[l], g_moba_k[l], g_moba_out[l], g_cq[l], g_ckv[l],
            w_uq[l], w_ukv[l], g_mla_q[l], g_mla_k[l], g_mla_out[l], w_out[l], g_mlp_norm[l],
            w_up[l], w_down[l])
    return x
```

```cpp
#include <hip/hip_runtime.h>
#include <cstdio>
#include <cstdint>

#ifndef MK_PER_PHASE
#define MK_PER_PHASE 0
#endif
#ifndef DBL_MOBA
#define DBL_MOBA 1
#endif
#ifndef DBL_MLA
#define DBL_MLA 1
#endif
#ifndef DBL_P1
#define DBL_P1 1
#endif
#ifndef DBL_P6
#define DBL_P6 1
#endif
#ifndef DBL_M3
#define DBL_M3 1
#endif
#ifndef DBL_P2
#define DBL_P2 1
#endif
#ifndef DBL_OWN
#define DBL_OWN 1
#endif
#ifndef DBL_SEL
#define DBL_SEL 1
#endif
#ifndef DBL_P0
#define DBL_P0 1
#endif
#ifndef DBL_KP
#define DBL_KP 1
#endif
#ifndef DBL_BAR
#define DBL_BAR 1
#endif
#ifndef DBL_P2G
#define DBL_P2G 1
#endif

#define LAS __attribute__((address_space(3)))
#define GAS __attribute__((address_space(1)))
typedef _Float16 f16;
typedef _Float16 h8 __attribute__((ext_vector_type(8)));
typedef _Float16 h2 __attribute__((ext_vector_type(2)));
typedef short s16x4 __attribute__((ext_vector_type(4)));
typedef short s16x8 __attribute__((ext_vector_type(8)));
typedef float f32x2 __attribute__((ext_vector_type(2)));
typedef float f32x4 __attribute__((ext_vector_type(4)));
typedef float f32x16 __attribute__((ext_vector_type(16)));
typedef unsigned u32x2 __attribute__((ext_vector_type(2)));
typedef unsigned u32x4 __attribute__((ext_vector_type(4)));
typedef int i32x4 __attribute__((ext_vector_type(4)));
typedef int i32x8 __attribute__((ext_vector_type(8)));
typedef GAS unsigned gu32;

constexpr int NBATCH = 4, SEQ = 8192, T = NBATCH * SEQ, DM = 1024, DEPTH = 2, DIN = 2984, NPROJ = 3072, DFF = 4096;
constexpr float EPS = 1e-6f;
constexpr float LOG2E = 1.4426950408889634f;
constexpr int PC_MQ = 0, PC_MK = 256, PC_MV = 512, PC_MO = 1024, PC_AQ = 1536, PC_AK = 1792, PC_AV = 2048, PC_CQ = 2304, PC_GATE = 2688, PC_KPE = 2720, PC_CKV = 2816;
constexpr int PC_LK = PC_CQ;
constexpr int LQP = 512;

constexpr size_t MiB = 1u << 20;
constexpr size_t WS_CTL = 0, CTL_ZERO_BYTES = 65536;
constexpr size_t WS_W = 4 * MiB, W_LAYER = 25 * MiB;
constexpr size_t WO_IN = 0, WO_UQ = 6 * MiB, WO_UKV = WO_UQ + 512 * 384 * 2, WO_OUT = 7 * MiB, WO_UP = 9 * MiB, WO_DOWN = 17 * MiB;
constexpr size_t WS_SM = 54 * MiB;
constexpr size_t SM_SSQA = 0, SM_SSQB = 2 * MiB, SM_CQP = 4 * MiB, SM_CKVP = 5 * MiB, SM_GATES = 6 * MiB, SM_KSUM = 7 * MiB, SM_BA = 7 * MiB + 512 * 1024,
                 SM_MST = SM_BA + 65536, SM_NST = 8 * MiB, SM_COSP = 9 * MiB, SM_SINP = 10 * MiB, SM_COSD = 11 * MiB, SM_SIND = 13 * MiB, SM_BTG = 15 * MiB,
                 SM_XS = 5 * MiB + 512 * 1024,
                 SM_XS2 = 5 * MiB + 640 * 1024;
constexpr size_t WS_X16 = 70 * MiB;
constexpr size_t WS_X8I = 166 * MiB;
constexpr size_t WS_MIX = 134 * MiB;
constexpr size_t WS_PROJ = 198 * MiB;
constexpr size_t WS_LQ = 390 * MiB, WS_LKV = 422 * MiB;
constexpr size_t WS_H = 198 * MiB;
constexpr size_t WS_PART = 454 * MiB;
constexpr size_t WS_PARTL = 502 * MiB;
constexpr size_t WS_LIST = 504 * MiB;
constexpr size_t WS_END = 512 * MiB;
constexpr int CTL_WMAX = 16, CTL_WDONE = 32;
constexpr int CTL_CNT = 8192;

constexpr int LDS_BYTES = 163840, MISC_OFF = LDS_BYTES - 512;

struct Params {
    const float* in[23];
    float* out;
    unsigned char* ws;
    int ph_lo, ph_hi;
};

#define LDS_WAIT() asm volatile("s_waitcnt lgkmcnt(0)" ::: "memory")
#define VM_WAIT() asm volatile("s_waitcnt vmcnt(0)" ::: "memory")
#define RLX_AGENT __ATOMIC_RELAXED, __HIP_MEMORY_SCOPE_AGENT

__device__ __forceinline__ int tidx() { int t = threadIdx.x; asm volatile("" : "+v"(t)); return t; }
__device__ __forceinline__ unsigned pkh(float lo, float hi) { f32x2 v = {lo, hi}; h2 h = __builtin_convertvector(v, h2); return __builtin_bit_cast(unsigned, h); }
typedef __bf16 bf2_t __attribute__((ext_vector_type(2)));
__device__ __forceinline__ unsigned pkb(float lo, float hi) { f32x2 v = {lo, hi}; bf2_t b = __builtin_convertvector(v, bf2_t); return __builtin_bit_cast(unsigned, b); }
constexpr float F8MAX = 448.0f;
__device__ __forceinline__ unsigned pk8(float a, float b, float c, float d) { int w = __builtin_amdgcn_cvt_pk_fp8_f32(a, b, 0, false); w = __builtin_amdgcn_cvt_pk_fp8_f32(c, d, w, true); return (unsigned)w; }
__device__ __forceinline__ unsigned pk8c(float a, float b, float c, float d, float mx) {
    return pk8(__builtin_fminf(__builtin_fmaxf(a, -mx), mx), __builtin_fminf(__builtin_fmaxf(b, -mx), mx), __builtin_fminf(__builtin_fmaxf(c, -mx), mx), __builtin_fminf(__builtin_fmaxf(d, -mx), mx)); }
constexpr float XQ_RANGE = 6.0f;
constexpr float F8_WUP = 32.0f, F8_WDOWN = 128.0f, F8_H = 4.0f, F8_WOUT = 64.0f;
__device__ __forceinline__ f32x2 unpkh(unsigned u) { h2 h = __builtin_bit_cast(h2, u); return __builtin_convertvector(h, f32x2); }
__device__ __forceinline__ int crow(int r, int hi) { return (r & 3) + 8 * (r >> 2) + 4 * hi; }
__device__ __forceinline__ float swap_add(float v) { auto rr = __builtin_amdgcn_permlane32_swap(__float_as_uint(v), __float_as_uint(v), false, false); return __uint_as_float(rr[0]) + __uint_as_float(rr[1]); }
__device__ __forceinline__ float swap_max(float v) { auto rr = __builtin_amdgcn_permlane32_swap(__float_as_uint(v), __float_as_uint(v), false, false); return fmaxf(__uint_as_float(rr[0]), __uint_as_float(rr[1])); }
__device__ __forceinline__ float wave_max(float v) {
#pragma unroll
    for (int o = 1; o < 64; o <<= 1) v = fmaxf(v, __shfl_xor(v, o));
    return v;
}
__device__ __forceinline__ unsigned pki8(float a, float b, float c, float d) {
    const int ia = (int)__builtin_rintf(a), ib = (int)__builtin_rintf(b), ic = (int)__builtin_rintf(c), id = (int)__builtin_rintf(d);
    return (unsigned)(ia & 255) | ((unsigned)(ib & 255) << 8) | ((unsigned)(ic & 255) << 16) | ((unsigned)id << 24);
}
__device__ __forceinline__ f32x4 tof(const f32x4& v) { return v; }
__device__ __forceinline__ f32x4 tof(const i32x4& v) { return __builtin_convertvector(v, f32x4); }
__device__ __forceinline__ float wave_sum(float v) {
#pragma unroll
    for (int o = 1; o < 64; o <<= 1) v += __shfl_xor(v, o);
    return v;
}

namespace pg8 {
constexpr int BM = 256, BK = 64, HALF = 128, HTB = HALF * BK * 2, STAGE_BYTES = 8 * HTB, NXCD = 8, WGM = 8;
__host__ __device__ __forceinline__ int lds_byte(int r, int c) { const int st = (r >> 4) * 2 + (c >> 5), rr = r & 15, cc = c & 31, ob = rr * 64 + cc * 2; return st * 1024 + (ob ^ (((ob >> 9) & 1) << 5)); }
__host__ __device__ __forceinline__ void stage_rc(int b, int& R, int& C) { const int st = b / 1024, sb = b % 1024, swz = sb ^ (((sb >> 9) & 1) << 5); R = (st >> 1) * 16 + swz / 64; C = (st & 1) * 32 + (swz % 64) / 2; }
__host__ __device__ __forceinline__ int perm32(int rho) { const int n = rho >> 4, i = rho & 15; return 8 * (i >> 2) + 4 * n + (i & 3); }
template <bool I8> struct AccSel { typedef f32x4 type; };
template <> struct AccSel<true> { typedef i32x4 type; };
struct Unit { int pm, pn, ui; };
struct Gemm { const f16* A; const f16* Bt; int M, N, K, lda, ldb; };
struct StaticOrder {
    int nM, nN, nwg, G, c, pnoff, pnskip;
    __device__ void init(int M, int N, int G_, int c_, int pnoff_ = 0, int pnskip_ = 1 << 20) { nM = M / BM; nN = N / BM; nwg = nM * nN; G = G_; c = c_; pnoff = pnoff_; pnskip = pnskip_; }
    __device__ bool next(int i, Unit& u) const {
        const long L = (long)i * G + c; if (L >= nwg) return false;
        int wgid = (int)L; { const int q = nwg / NXCD, r = nwg % NXCD, xcd = wgid % NXCD, off = wgid / NXCD; wgid = (xcd < r ? xcd * (q + 1) : r * (q + 1) + (xcd - r) * q) + off; }
        const int nig = WGM * nN, gid = wgid / nig, fm = gid * WGM, gsz = (nM - fm) < WGM ? (nM - fm) : WGM;
        u.pm = fm + ((wgid % nig) % gsz); u.pn = (wgid % nig) / gsz + pnoff; if (u.pn >= pnskip) u.pn += 2; return true;
    }
};

template <class Epi, bool ALIGN_EPI, int MODE = 0>
__device__ __forceinline__ void gemm_phase(LAS unsigned char* lds, const Gemm g, const StaticOrder& S, const Epi& E, const int tid_in) {
    constexpr bool F8 = (MODE == 1), I8 = (MODE == 2);
    int tid = tid_in; asm volatile("" : "+v"(tid));
    const int wid = __builtin_amdgcn_readfirstlane(tid >> 6), lane = tid & 63, wr = wid >> 2, wc = wid & 3, fr = lane & 15, fq = lane >> 4;
    const int K = g.K, nt = K / BK;
    unsigned voffA[2], voffB[2];
#pragma unroll
    for (int i = 0; i < 2; ++i) { int R, C; stage_rc(tid * 16 + i * 8192, R, C); const int Rb = (R & ~31) + perm32(R & 31);
        voffA[i] = (unsigned)(R * g.lda + C) * 2u; voffB[i] = (unsigned)(Rb * g.ldb + C) * 2u; }
    const size_t kstep = (size_t)(BK * 2);
    const size_t hstepA = (size_t)HALF * g.lda * 2, hstepB = (size_t)HALF * g.ldb * 2;
    const size_t tstepA = 2 * hstepA, tstepB = 2 * hstepB;
    const unsigned ldsw = (unsigned)wid * 1024u;
    const int aoff = lds_byte(wr * 64 + fr, fq * 8), boff = lds_byte(wc * 32 + fr, fq * 8);
#define PG8_SA(b, h) (((b) * 2 + (h)) * HTB)
#define PG8_SB(b, h) ((4 + (b) * 2 + (h)) * HTB)
#define PG8_STAGE(bufoff, gbase, voff) do { _Pragma("unroll") for (int _i = 0; _i < 2; ++_i) \
        __builtin_amdgcn_global_load_lds((const unsigned*)((const char*)(gbase) + (voff)[_i]), (LAS unsigned*)(lds + (bufoff) + ldsw + _i * 8192), 16, 0, 0); } while (0)
#define PG8_LDA(dst, b, h) do { _Pragma("unroll") for (int m = 0; m < 4; ++m) _Pragma("unroll") for (int k = 0; k < 2; ++k) dst[m][k] = *(const LAS h8*)(lds + PG8_SA(b, h) + aoff + m * 2048 + k * 1024); } while (0)
#define PG8_LDB(dst, b, h) do { _Pragma("unroll") for (int n = 0; n < 2; ++n) _Pragma("unroll") for (int k = 0; k < 2; ++k) dst[n][k] = *(const LAS h8*)(lds + PG8_SB(b, h) + boff + n * 2048 + k * 1024); } while (0)
#define PG8_CAT(x) __builtin_shufflevector(__builtin_bit_cast(i32x4, x[0]), __builtin_bit_cast(i32x4, x[1]), 0, 1, 2, 3, 4, 5, 6, 7)
#define PG8_MMA(ai, bj, At, Bt) do { __builtin_amdgcn_s_setprio(1); _Pragma("unroll") for (int m = 0; m < 4; ++m) _Pragma("unroll") for (int n = 0; n < 2; ++n) { \
        if constexpr (F8) { const i32x8 b8_ = PG8_CAT(Bt[n]), a8_ = PG8_CAT(At[m]); asm volatile("v_mfma_f32_16x16x128_f8f6f4 %0, %1, %2, %0" : "+v"(acc[ai][bj][m][n]) : "v"(b8_), "v"(a8_)); } \
        else if constexpr (I8) { _Pragma("unroll") for (int k = 0; k < 2; ++k) acc[ai][bj][m][n] = __builtin_amdgcn_mfma_i32_16x16x64_i8(__builtin_bit_cast(i32x4, Bt[n][k]), __builtin_bit_cast(i32x4, At[m][k]), acc[ai][bj][m][n], 0, 0, 0); } \
        else { _Pragma("unroll") for (int k = 0; k < 2; ++k) acc[ai][bj][m][n] = __builtin_amdgcn_mfma_f32_16x16x32_f16(Bt[n][k], At[m][k], acc[ai][bj][m][n], 0, 0, 0); } } \
        __builtin_amdgcn_s_setprio(0); } while (0)
#define PG8_WAIT_V(n) asm volatile("s_waitcnt vmcnt(" #n ")" ::: "memory")
#define PG8_WAIT_L(n) asm volatile("s_waitcnt lgkmcnt(" #n ")" ::: "memory")
#define PG8_BAR __builtin_amdgcn_s_barrier()
#define PG8_SCHED __builtin_amdgcn_sched_barrier(0)
    Unit cur, nxt; int ui = 0;
    if (!S.next(0, cur)) return;
    cur.ui = 0;
    typedef typename AccSel<I8>::type AccT;
    AccT acc[2][2][4][2];
#pragma unroll
    for (int a = 0; a < 2; ++a)
#pragma unroll
        for (int b = 0; b < 2; ++b)
#pragma unroll
            for (int m = 0; m < 4; ++m)
#pragma unroll
                for (int n = 0; n < 2; ++n) acc[a][b][m][n] = (AccT){0, 0, 0, 0};
    h8 At[4][2], B0[2][2], B1[2][2];
    const char* cA = (const char*)g.A + (size_t)cur.pm * tstepA; const char* cB = (const char*)g.Bt + (size_t)cur.pn * tstepB;
    PG8_STAGE(PG8_SB(0, 0), cB, voffB); PG8_STAGE(PG8_SB(0, 1), cB + hstepB, voffB); PG8_STAGE(PG8_SA(0, 0), cA, voffA); PG8_STAGE(PG8_SA(0, 1), cA + hstepA, voffA);
    if (wr == 1) PG8_BAR;
    PG8_WAIT_V(2); PG8_BAR;
    PG8_STAGE(PG8_SB(1, 0), cB + kstep, voffB); PG8_STAGE(PG8_SA(1, 0), cA + kstep, voffA); PG8_STAGE(PG8_SB(1, 1), cB + hstepB + kstep, voffB);
    PG8_WAIT_V(6); PG8_BAR;
    for (;;) {
        const bool has_next = S.next(ui + 1, nxt); nxt.ui = ui + 1;
        const char* nA = has_next ? (const char*)g.A + (size_t)nxt.pm * tstepA : cA; const char* nB = has_next ? (const char*)g.Bt + (size_t)nxt.pn * tstepB : cB;
        for (int t = 0; t < nt; t += 2) {
            const bool last = (t == nt - 2);
            const char* a1 = cA + (size_t)(t + 1) * kstep;
            const char* a2 = last ? nA : cA + (size_t)(t + 2) * kstep; const char* b2 = last ? nB : cB + (size_t)(t + 2) * kstep;
            const char* a3 = a2 + kstep; const char* b3 = b2 + kstep;
            PG8_LDB(B0, 0, 0); PG8_LDB(B1, 0, 1); PG8_SCHED; PG8_LDA(At, 0, 0); PG8_STAGE(PG8_SA(1, 1), a1 + hstepA, voffA);
            PG8_WAIT_V(8); PG8_WAIT_L(0); PG8_BAR; PG8_MMA(0, 0, At, B0); PG8_MMA(0, 1, At, B1); PG8_BAR; PG8_SCHED;
            PG8_LDA(At, 0, 1); PG8_STAGE(PG8_SB(0, 0), b2, voffB); PG8_STAGE(PG8_SB(0, 1), b2 + hstepB, voffB); PG8_STAGE(PG8_SA(0, 0), a2, voffA);
            PG8_WAIT_V(8); PG8_WAIT_L(0); PG8_BAR; PG8_MMA(1, 0, At, B0); PG8_MMA(1, 1, At, B1); PG8_BAR; PG8_SCHED;
            PG8_LDB(B0, 1, 0); PG8_LDB(B1, 1, 1); PG8_SCHED; PG8_LDA(At, 1, 0); PG8_STAGE(PG8_SA(0, 1), a2 + hstepA, voffA);
            PG8_WAIT_V(8); PG8_WAIT_L(0); PG8_BAR; PG8_MMA(0, 0, At, B0); PG8_MMA(0, 1, At, B1); PG8_BAR; PG8_SCHED;
            PG8_LDA(At, 1, 1); PG8_STAGE(PG8_SB(1, 0), b3, voffB); PG8_STAGE(PG8_SB(1, 1), b3 + hstepB, voffB); PG8_STAGE(PG8_SA(1, 0), a3, voffA);
            PG8_WAIT_V(8); PG8_WAIT_L(0); PG8_BAR; PG8_MMA(1, 0, At, B0); PG8_MMA(1, 1, At, B1); PG8_BAR; PG8_SCHED;
        }
        if constexpr (ALIGN_EPI) { if (wr == 0) PG8_BAR; }
        if constexpr (F8) asm volatile("s_nop 15\n\ts_nop 15" ::: "memory");
        { int le_; asm volatile("v_mbcnt_lo_u32_b32 %0, -1, 0\n\tv_mbcnt_hi_u32_b32 %0, -1, %0" : "=v"(le_));
          E(acc, cur, wr, wc, le_ & 15, le_ >> 4); }
        if (!has_next) break;
#pragma unroll
        for (int a = 0; a < 2; ++a)
#pragma unroll
            for (int b = 0; b < 2; ++b)
#pragma unroll
                for (int m = 0; m < 4; ++m)
#pragma unroll
                    for (int n = 0; n < 2; ++n) acc[a][b][m][n] = (AccT){0, 0, 0, 0};
        cur = nxt; cA = nA; cB = nB; ++ui;
        if constexpr (ALIGN_EPI) { if (wr == 1) PG8_BAR; }
    }
    PG8_WAIT_V(0);
    if constexpr (!ALIGN_EPI) { if (wr == 0) PG8_BAR; }
    PG8_BAR;
#undef PG8_SA
#undef PG8_SB
#undef PG8_STAGE
#undef PG8_LDA
#undef PG8_LDB
#undef PG8_MMA
#undef PG8_CAT
#undef PG8_WAIT_V
#undef PG8_WAIT_L
#undef PG8_BAR
#undef PG8_SCHED
}
}

typedef f32x4 Acc[2][2][4][2];
__device__ __forceinline__ float sum_parts(const float* p, int n4) { float s = 0.f; for (int i = 0; i < n4; ++i) { const f32x4 v = *(const f32x4*)(p + 4 * i); s += (v[0] + v[1]) + (v[2] + v[3]); } return s; }


constexpr int ROWSC_OFF = 131072;
__device__ __forceinline__ void rowscale_table(LAS unsigned char* lds, const pg8::StaticOrder& S, const float* parts, int nparts4, float inv_dim, int tid, const float* rowmul = nullptr, float smul = 1.0f) {
    LAS float* tab = (LAS float*)(lds + ROWSC_OFF);
    pg8::Unit u;
    for (int i = 0; i < 8 && S.next(i, u); ++i) {
        if (tid < 256) { const int row = u.pm * 256 + tid; float sc_ = __builtin_amdgcn_rsqf(sum_parts(parts + (size_t)row * nparts4 * 4, nparts4) * inv_dim + EPS); if (rowmul) sc_ = sc_ * rowmul[row] * smul; tab[i * 256 + tid] = sc_; }
    }
    LDS_WAIT(); __syncthreads();
}

struct EpiProj {
    f16* proj; LAS const float* rowsc; float* cqp; float* ckvp; float* gates; float* ksum;
    const float* cosp; const float* sinp; const float* gq; const float* gk;
    template <class AccArr>
    __device__ __forceinline__ void operator()(const AccArr& acc, const pg8::Unit& u, int wr, int wc, int fr, int fq) const {
        const int pn = u.pn;
        const int rbase = u.pm * 256 + wr * 64 + fr;
        const bool moba = (pn == 6 || pn == 7);
        const float qscale = (pn == 6) ? 0.125f * LOG2E : 1.0f;
        const float* gain = (pn == 6) ? gq : gk;
#pragma unroll
        for (int ai = 0; ai < 2; ++ai) {
            float ks[2][2][4];
#pragma unroll
            for (int bj = 0; bj < 2; ++bj)
#pragma unroll
                for (int n = 0; n < 2; ++n)
#pragma unroll
                    for (int e = 0; e < 4; ++e) ks[bj][n][e] = 0.f;
#pragma unroll
            for (int m = 0; m < 4; ++m) {
                const int row = rbase + ai * 128 + m * 16;
                const float rstd = rowsc[u.ui * 256 + (row & 255)];
                f32x4 v[2][2];
#pragma unroll
                for (int bj = 0; bj < 2; ++bj)
#pragma unroll
                    for (int n = 0; n < 2; ++n) v[bj][n] = tof(acc[ai][bj][m][n]) * rstd;
                if (moba) {
                    float ss = 0.f;
#pragma unroll
                    for (int bj = 0; bj < 2; ++bj)
#pragma unroll
                        for (int n = 0; n < 2; ++n) ss += (v[bj][n][0] * v[bj][n][0] + v[bj][n][1] * v[bj][n][1]) + (v[bj][n][2] * v[bj][n][2] + v[bj][n][3] * v[bj][n][3]);
                    ss += __shfl_xor(ss, 16); ss += __shfl_xor(ss, 32);
                    const float hr = __builtin_amdgcn_rsqf(ss * (1.0f / 64.0f) + EPS);
#pragma unroll
                    for (int bj = 0; bj < 2; ++bj)
#pragma unroll
                        for (int n = 0; n < 2; ++n) { const f32x4 gv = *(const f32x4*)(gain + 32 * bj + 8 * fq + 4 * n); v[bj][n] = v[bj][n] * hr * gv; }
                    {
                        f32x4 o0, o1;
#pragma unroll
                        for (int e = 0; e < 4; ++e) { o0[e] = __shfl_xor(v[0][0][e], 16); o1[e] = __shfl_xor(v[0][1][e], 16); }
                        if (fq < 2) {
                            const f32x4 c0 = *(const f32x4*)(cosp + (size_t)row * 8), c1 = *(const f32x4*)(cosp + (size_t)row * 8 + 4);
                            const f32x4 s0 = *(const f32x4*)(sinp + (size_t)row * 8), s1 = *(const f32x4*)(sinp + (size_t)row * 8 + 4);
                            const float sg = (fq == 0) ? -1.0f : 1.0f;
                            v[0][0] = v[0][0] * c0 + o0 * s0 * sg; v[0][1] = v[0][1] * c1 + o1 * s1 * sg;
                        }
                    }
                    if (pn == 7) {
#pragma unroll
                        for (int bj = 0; bj < 2; ++bj)
#pragma unroll
                            for (int n = 0; n < 2; ++n)
#pragma unroll
                                for (int e = 0; e < 4; ++e) ks[bj][n][e] += v[bj][n][e];
                    }
                    f16* dst = proj + (size_t)row * NPROJ + (pn == 6 ? PC_AQ : PC_AK) + 64 * wc + 8 * fq;
#pragma unroll
                    for (int bj = 0; bj < 2; ++bj) { u32x4 w; w.x = pkh(v[bj][0][0] * qscale, v[bj][0][1] * qscale); w.y = pkh(v[bj][0][2] * qscale, v[bj][0][3] * qscale);
                        w.z = pkh(v[bj][1][0] * qscale, v[bj][1][1] * qscale); w.w = pkh(v[bj][1][2] * qscale, v[bj][1][3] * qscale); *(u32x4*)(dst + 32 * bj) = w; }
                } else {
                    f16* dst = proj + (size_t)row * NPROJ + pn * 256 + 32 * wc + 8 * fq;
#pragma unroll
                    for (int bj = 0; bj < 2; ++bj) { u32x4 w;
                        if (pn == 8) { w.x = pkb(v[bj][0][0], v[bj][0][1]); w.y = pkb(v[bj][0][2], v[bj][0][3]); w.z = pkb(v[bj][1][0], v[bj][1][1]); w.w = pkb(v[bj][1][2], v[bj][1][3]); }
                        else { w.x = pkh(v[bj][0][0], v[bj][0][1]); w.y = pkh(v[bj][0][2], v[bj][0][3]); w.z = pkh(v[bj][1][0], v[bj][1][1]); w.w = pkh(v[bj][1][2], v[bj][1][3]); }
                        *(u32x4*)(dst + 128 * bj) = w; }
                    if (pn >= 9) {
                        float s0 = 0.f, s1 = 0.f;
#pragma unroll
                        for (int n = 0; n < 2; ++n) { s0 += (v[0][n][0] * v[0][n][0] + v[0][n][1] * v[0][n][1]) + (v[0][n][2] * v[0][n][2] + v[0][n][3] * v[0][n][3]);
                                                      s1 += (v[1][n][0] * v[1][n][0] + v[1][n][1] * v[1][n][1]) + (v[1][n][2] * v[1][n][2] + v[1][n][3] * v[1][n][3]); }
                        float s = (pn == 10) ? s0 : (s0 + s1);
                        s += __shfl_xor(s, 16); s += __shfl_xor(s, 32);
                        if (fq == 0) { if (pn == 9) cqp[(size_t)row * 8 + wc] = s; else if (pn == 10) cqp[(size_t)row * 8 + 4 + wc] = s; else ckvp[(size_t)row * 4 + wc] = s; }
                        if (pn == 10 && wc == 0 && fq == 0) { *(f32x4*)(gates + (size_t)row * 8) = v[1][0]; *(f32x4*)(gates + (size_t)row * 8 + 4) = v[1][1]; }
                    }
                }
            }
            if (pn == 7) {
#pragma unroll
                for (int bj = 0; bj < 2; ++bj)
#pragma unroll
                    for (int n = 0; n < 2; ++n)
#pragma unroll
                        for (int e = 0; e < 4; ++e) { float s = ks[bj][n][e]; s += __shfl_xor(s, 1); s += __shfl_xor(s, 2); s += __shfl_xor(s, 4); s += __shfl_xor(s, 8); ks[bj][n][e] = s; }
                if (fr == 0) {
                    float* dst = ksum + (size_t)((u.pm * 256 + ai * 128 + wr * 64) >> 6) * 256 + 64 * wc + 8 * fq;
#pragma unroll
                    for (int bj = 0; bj < 2; ++bj) { *(f32x4*)(dst + 32 * bj) = (f32x4){ks[bj][0][0], ks[bj][0][1], ks[bj][0][2], ks[bj][0][3]};
                                                     *(f32x4*)(dst + 32 * bj + 4) = (f32x4){ks[bj][1][0], ks[bj][1][1], ks[bj][1][2], ks[bj][1][3]}; }
                }
            }
        }
    }
};

template <int MODE> struct EpiScale {
    f16* O; int ldc; LAS const float* rowsc; int vbf;
    __device__ __forceinline__ void operator()(const Acc& acc, const pg8::Unit& u, int wr, int wc, int fr, int fq) const {
        const int rbase = u.pm * 256 + wr * 64 + fr; const int col0 = u.pn * 256 + 32 * wc + 8 * fq;
#pragma unroll
        for (int ai = 0; ai < 2; ++ai)
#pragma unroll
            for (int m = 0; m < 4; ++m) {
                const int row = rbase + ai * 128 + m * 16;
                float sc = rowsc[u.ui * 256 + (row & 255)];
                if (MODE == 1) sc = sc * sc;
                f16* dst = O + (size_t)row * ldc + col0;
#pragma unroll
                for (int bj = 0; bj < 2; ++bj) {
                    f32x4 v0 = acc[ai][bj][m][0], v1 = acc[ai][bj][m][1];
                    if (MODE == 1) {
#pragma unroll
                        for (int e = 0; e < 4; ++e) { const float a = fmaxf(v0[e], 0.f), b = fmaxf(v1[e], 0.f); v0[e] = a * a; v1[e] = b * b; }
                    }
                    v0 = v0 * sc; v1 = v1 * sc;
                    u32x4 w;
                    if (MODE == 0 && vbf && wc >= 2) { w.x = pkb(v0[0], v0[1]); w.y = pkb(v0[2], v0[3]); w.z = pkb(v1[0], v1[1]); w.w = pkb(v1[2], v1[3]); }
                    else { w.x = pkh(v0[0], v0[1]); w.y = pkh(v0[2], v0[3]); w.z = pkh(v1[0], v1[1]); w.w = pkh(v1[2], v1[3]); }
                    *(u32x4*)(dst + 128 * bj) = w;
                }
            }
    }
};

struct EpiAct8 {
    unsigned char* O; int ldc; LAS const float* rowsc;
    template <class AccArr>
    __device__ __forceinline__ void operator()(const AccArr& acc, const pg8::Unit& u, int wr, int wc, int fr, int fq) const {
        const int rbase = u.pm * 256 + wr * 64 + fr; const int col0 = u.pn * 256 + 32 * wc + 8 * fq;
        float mx = F8MAX, kk = F8_H; asm volatile("" : "+s"(mx), "+s"(kk));
#pragma unroll
        for (int ai = 0; ai < 2; ++ai)
#pragma unroll
            for (int m = 0; m < 4; ++m) {
                const int row = rbase + ai * 128 + m * 16;
                float sc = rowsc[u.ui * 256 + (row & 255)];
                sc = sc * sc * kk;
                unsigned char* dst = O + (size_t)row * ldc + col0;
#pragma unroll
                for (int bj = 0; bj < 2; ++bj) {
                    f32x4 v0 = tof(acc[ai][bj][m][0]), v1 = tof(acc[ai][bj][m][1]);
#pragma unroll
                    for (int e = 0; e < 4; ++e) { const float a = fmaxf(v0[e], 0.f), b = fmaxf(v1[e], 0.f); v0[e] = __builtin_fminf(a * a * sc, mx); v1[e] = __builtin_fminf(b * b * sc, mx); }
                    u32x2 w; w.x = pk8(v0[0], v0[1], v0[2], v0[3]); w.y = pk8(v1[0], v1[1], v1[2], v1[3]);
                    *(u32x2*)(dst + 128 * bj) = w;
                }
            }
    }
};

struct EpiRes {
    const float* res; float* out; f16* x16; float* ssq; int feed;
    int f8x; float ascale;
    unsigned char* x8i; float* xs; LAS const float* rowsc;
    __device__ __forceinline__ void operator()(const Acc& acc, const pg8::Unit& u, int wr, int wc, int fr, int fq) const {
        const int rbase = u.pm * 256 + wr * 64 + fr; const int col0 = u.pn * 256 + 32 * wc + 8 * fq;
        float mx = F8MAX; asm volatile("" : "+s"(mx));
#pragma unroll
        for (int ai = 0; ai < 2; ++ai)
#pragma unroll
            for (int m = 0; m < 4; ++m) {
                const int row = rbase + ai * 128 + m * 16; const size_t off = (size_t)row * DM + col0;
                float ss = 0.f;
#pragma unroll
                for (int bj = 0; bj < 2; ++bj) {
                    const f32x4 r0 = *(const f32x4*)(res + off + 128 * bj), r1 = *(const f32x4*)(res + off + 128 * bj + 4);
                    const f32x4 v0 = r0 + acc[ai][bj][m][0] * ascale, v1 = r1 + acc[ai][bj][m][1] * ascale;
                    *(f32x4*)(out + off + 128 * bj) = v0; *(f32x4*)(out + off + 128 * bj + 4) = v1;
                    if (feed) {
                    if (f8x == 1) { u32x2 w; w.x = pk8c(v0[0], v0[1], v0[2], v0[3], mx); w.y = pk8c(v1[0], v1[1], v1[2], v1[3], mx); *(u32x2*)((unsigned char*)x16 + off + 128 * bj) = w; }
                    else { if (f8x == 0) { u32x4 w; w.x = pkh(v0[0], v0[1]); w.y = pkh(v0[2], v0[3]); w.z = pkh(v1[0], v1[1]); w.w = pkh(v1[2], v1[3]);
                    *(u32x4*)(x16 + off + 128 * bj) = w; }
                    if (x8i) { const float qs = rowsc[u.ui * 256 + (row & 255)] * (127.0f / XQ_RANGE); float lim = 127.0f; asm volatile("" : "+s"(lim));
                        f32x4 a0 = v0 * qs, a1 = v1 * qs;
#pragma unroll
                        for (int e = 0; e < 4; ++e) { a0[e] = __builtin_fminf(__builtin_fmaxf(a0[e], -lim), lim); a1[e] = __builtin_fminf(__builtin_fmaxf(a1[e], -lim), lim); }
                        u32x2 w8; w8.x = pki8(a0[0], a0[1], a0[2], a0[3]); w8.y = pki8(a1[0], a1[1], a1[2], a1[3]); *(u32x2*)(x8i + off + 128 * bj) = w8; } }
                    ss += (v0[0] * v0[0] + v0[1] * v0[1]) + (v0[2] * v0[2] + v0[3] * v0[3]) + (v1[0] * v1[0] + v1[1] * v1[1]) + (v1[2] * v1[2] + v1[3] * v1[3]);
                    }
                }
                if (feed) {
                ss += __shfl_xor(ss, 16); ss += __shfl_xor(ss, 32);
                if (fq == 0) ssq[(size_t)row * 16 + u.pn * 4 + wc] = ss;
                if (x8i && fq == 0 && u.pn == 0 && wc == 0) xs[row] = XQ_RANGE / (127.0f * rowsc[u.ui * 256 + (row & 255)]);
                }
            }
    }
};

#define XB_TMO      128
#define XB_XCNT(j)  (256  + 64 * (j))
#define XB_XSUB(j)  (1280 + 64 * (j))
#define XB_XGEN(j)  (2304 + 64 * (j))
#define XB_TOP      3328
#define XB_TOPGEN   3392
#define XCD_BAR_WORDS 3456
#define XB_SPIN_CAP (1u << 22)
__device__ __forceinline__ unsigned xb_ld(unsigned* p)              { return __hip_atomic_load(p, __ATOMIC_RELAXED, __HIP_MEMORY_SCOPE_AGENT); }
__device__ __forceinline__ unsigned xb_add(unsigned* p, unsigned v) { return __hip_atomic_fetch_add(p, v, __ATOMIC_RELAXED, __HIP_MEMORY_SCOPE_AGENT); }
__device__ __forceinline__ unsigned xb_xcc_id() { return (unsigned)__builtin_amdgcn_s_getreg((3 << 11) | 20) & 0xFu; }
#define XB_SPIN(cond, bar) do { unsigned _sp = 0; while (cond) { __builtin_amdgcn_s_sleep(1); \
    if ((++_sp & 255u) == 0u) { if (xb_ld(&(bar)[XB_TMO])) break; if (_sp > XB_SPIN_CAP) { atomicAdd(&(bar)[XB_TMO], 1u); break; } } } } while (0)
struct XcdBarrier { unsigned* bar; unsigned x; volatile LAS unsigned* st; };
__device__ __forceinline__ XcdBarrier xcd_barrier_post(unsigned* bar, volatile LAS unsigned* st) {
    XcdBarrier b; b.bar = bar; b.x = xb_xcc_id(); b.st = st;
    if (threadIdx.x == 0) (void)xb_add(&bar[XB_XCNT(b.x)], 1u);
    return b;
}
__device__ __forceinline__ void xcd_barrier_complete(unsigned* bar, unsigned x, unsigned& nloc, unsigned& nx) {
    const unsigned G = gridDim.x * gridDim.y * gridDim.z;
    unsigned sum, cnt, mine, sp = 0u;
    for (;;) {
        sum = 0u; cnt = 0u; mine = 0u;
#pragma unroll
        for (unsigned j = 0; j < 16; ++j) { const unsigned c = xb_ld(&bar[XB_XCNT(j)]); sum += c; cnt += (c > 0u) ? 1u : 0u; mine = (j == x) ? c : mine; }
        if (sum == G) break;
        __builtin_amdgcn_s_sleep(1);
        if ((++sp & 255u) == 0u) { if (xb_ld(&bar[XB_TMO])) break; if (sp > XB_SPIN_CAP) { atomicAdd(&bar[XB_TMO], 1u); break; } }
    }
    nloc = mine > 0u ? mine : 1u; nx = cnt > 0u ? cnt : 1u;
}
__device__ __forceinline__ void xcd_barrier(const XcdBarrier& b) {
    asm volatile("s_waitcnt vmcnt(0)" ::: "memory");
    __syncthreads();
    if (threadIdx.x == 0) {
        unsigned* bar = b.bar;
        __builtin_amdgcn_s_waitcnt(0);
        unsigned nloc = b.st[0], nx = b.st[1];
        if (nloc == 0u) { xcd_barrier_complete(bar, b.x, nloc, nx); b.st[0] = nloc; b.st[1] = nx; }
        const unsigned old = xb_add(&bar[XB_XSUB(b.x)], 1u);
        const unsigned gen = old / nloc;
        if (old + 1u == (gen + 1u) * nloc) {
            __builtin_amdgcn_fence(__ATOMIC_RELEASE, "agent");
            asm volatile("s_waitcnt vmcnt(0)" ::: "memory");
            const unsigned og = xb_add(&bar[XB_TOP], 1u);
            const unsigned tg = og / nx;
            if (og + 1u == (tg + 1u) * nx) xb_add(&bar[XB_TOPGEN], 1u);
            else XB_SPIN(xb_ld(&bar[XB_TOPGEN]) == tg, bar);
            __builtin_amdgcn_fence(__ATOMIC_ACQUIRE, "agent");
            xb_add(&bar[XB_XGEN(b.x)], 1u);
            asm volatile("s_waitcnt vmcnt(0)" ::: "memory");
        } else {
            XB_SPIN(xb_ld(&bar[XB_XGEN(b.x)]) == gen, bar);
            __builtin_amdgcn_fence(__ATOMIC_ACQUIRE, "agent");
            asm volatile("s_waitcnt vmcnt(0)" ::: "memory");
        }
    }
    __syncthreads();
}

__device__ __forceinline__ int win_src(int n) {
    if (n < 1536) return n;
    if (n < 2048) { const int c = (n - 1536) & 255, t = (n - 1536) >> 8; const int bj = c >> 7, wc = (c >> 5) & 3, i = c & 31; return 1544 + 256 * t + 64 * wc + 32 * bj + i; }
    if (n < 2304) return 1544 + 512 + (n - 2048);
    if (n < 2688) return 2312 + (n - 2304);
    if (n < 2696) return 1536 + (n - 2688);
    if (n < 2720) return -1;
    if (n < 2752) return 2952 + (n - 2720);
    if (n < 2816) return -1;
    return 2696 + (n - 2816);
}
__device__ __forceinline__ int src_col(int kind, int n) {
    if (kind == 0) return n;
    if (kind == 1) return win_src(n);
    const int hd = n >> 7, d = n & 127; return d < 96 ? 96 * hd + d : -1;
}
__device__ __forceinline__ void transpose_item(const float* W, int K, int ldw, int N, int kind, const float* gain, f16* WT, LAS float* scr, int item, int lane, float f8s = 0.f, int qi8 = 0) {
    const int nblk = N / 32, kb = item / nblk, nb = item % nblk, k0 = 64 * kb, n0 = 32 * nb;
    const int sc0 = src_col(kind, n0), c4 = lane & 7;
#pragma unroll
    for (int i = 0; i < 8; ++i) { const int kk = 8 * i + (lane >> 3); f32x4 v = {0.f, 0.f, 0.f, 0.f};
        if (sc0 >= 0) { v = *(const f32x4*)(W + (size_t)(k0 + kk) * ldw + sc0 + 4 * c4); if (gain) v = v * gain[k0 + kk]; }
        LAS float* d = scr + kk * 33 + 4 * c4; d[0] = v[0]; d[1] = v[1]; d[2] = v[2]; d[3] = v[3]; }
    LDS_WAIT(); asm volatile("" ::: "memory");
    const int c = lane & 7;
#pragma unroll
    for (int j = 0; j < 4; ++j) { const int n = (lane >> 3) + 8 * j; const LAS float* s = scr + (8 * c) * 33 + n;
        if (qi8) { u32x2 o; o.x = pki8(s[0 * 33] * f8s, s[1 * 33] * f8s, s[2 * 33] * f8s, s[3 * 33] * f8s); o.y = pki8(s[4 * 33] * f8s, s[5 * 33] * f8s, s[6 * 33] * f8s, s[7 * 33] * f8s);
            *(u32x2*)((unsigned char*)WT + (size_t)(n0 + n) * K + k0 + 8 * c) = o; }
        else if (f8s > 0.f) { u32x2 o; o.x = pk8(s[0 * 33] * f8s, s[1 * 33] * f8s, s[2 * 33] * f8s, s[3 * 33] * f8s); o.y = pk8(s[4 * 33] * f8s, s[5 * 33] * f8s, s[6 * 33] * f8s, s[7 * 33] * f8s);
            *(u32x2*)((unsigned char*)WT + (size_t)(n0 + n) * K + k0 + 8 * c) = o; }
        else { u32x4 o; o.x = pkh(s[0 * 33], s[1 * 33]); o.y = pkh(s[2 * 33], s[3 * 33]); o.z = pkh(s[4 * 33], s[5 * 33]); o.w = pkh(s[6 * 33], s[7 * 33]);
        *(u32x4*)(WT + (size_t)(n0 + n) * K + k0 + 8 * c) = o; } }
    LDS_WAIT(); asm volatile("" ::: "memory");
}

constexpr int AT_K = 0, AT_V = 65536, AT_WS = 98304, AT_OST = 0;
__device__ __forceinline__ int rm_off(int row, int chunk) { return row * 128 + ((chunk ^ ((row >> 1) & 7)) << 4); }
__device__ __forceinline__ int v_st64(int k, int c) { const int kk = (k & ~0xC) | ((k & 4) << 1) | ((k & 8) >> 1); return ((kk >> 3) * 2 + (c >> 5)) * 512 + ((kk & 7) * 32 + (c & 31)) * 2; }
__device__ __forceinline__ int v_st128(int k, int c) { const int kk = (k & ~0xC) | ((k & 4) << 1) | ((k & 8) >> 1); return ((kk >> 3) * 4 + (c >> 5)) * 512 + ((kk & 7) * 32 + (c & 31)) * 2; }
__device__ __forceinline__ int v_rd_base(int lane) { return ((lane & 3) << 3) | (((lane >> 2) & 3) << 6) | (((lane >> 4) & 1) << 5) | (((lane >> 5) & 1) << 8); }
__device__ __forceinline__ s16x4 vtr(LAS const unsigned char* p) { return __builtin_amdgcn_ds_read_tr16_b64_v4i16((LAS s16x4*)p); }
__device__ __forceinline__ h8 mk8(s16x4 lo, s16x4 hi) { s16x8 v = {lo[0], lo[1], lo[2], lo[3], hi[0], hi[1], hi[2], hi[3]}; return __builtin_bit_cast(h8, v); }
__device__ __forceinline__ void pack_pb(const f32x16& p0, const f32x16& p1, s16x8& pa0, s16x8& pa1, s16x8& pa2, s16x8& pa3) {
#define PK4(P, B_, OUT) do { unsigned a0 = pkb(P[B_ + 0], P[B_ + 1]), a1 = pkb(P[B_ + 2], P[B_ + 3]); unsigned b0 = pkb(P[B_ + 4], P[B_ + 5]), b1 = pkb(P[B_ + 6], P[B_ + 7]); \
        auto r0 = __builtin_amdgcn_permlane32_swap(a0, b0, false, false); auto r1 = __builtin_amdgcn_permlane32_swap(a1, b1, false, false); \
        u32x4 w = {r0[0], r1[0], r0[1], r1[1]}; OUT = __builtin_bit_cast(s16x8, w); } while (0)
    PK4(p0, 0, pa0); PK4(p0, 8, pa1); PK4(p1, 0, pa2); PK4(p1, 8, pa3);
#undef PK4
}
__device__ __forceinline__ s16x8 mk8s(s16x4 lo, s16x4 hi) { s16x8 v = {lo[0], lo[1], lo[2], lo[3], hi[0], hi[1], hi[2], hi[3]}; return v; }
__device__ __forceinline__ void pack_p(const f32x16& p0, const f32x16& p1, h8& pa0, h8& pa1, h8& pa2, h8& pa3) {
#define PK4(P, B_, OUT) do { unsigned a0 = pkh(P[B_ + 0], P[B_ + 1]), a1 = pkh(P[B_ + 2], P[B_ + 3]); unsigned b0 = pkh(P[B_ + 4], P[B_ + 5]), b1 = pkh(P[B_ + 6], P[B_ + 7]); \
        auto r0 = __builtin_amdgcn_permlane32_swap(a0, b0, false, false); auto r1 = __builtin_amdgcn_permlane32_swap(a1, b1, false, false); \
        u32x4 w = {r0[0], r1[0], r0[1], r1[1]}; OUT = __builtin_bit_cast(h8, w); } while (0)
    PK4(p0, 0, pa0); PK4(p0, 8, pa1); PK4(p1, 0, pa2); PK4(p1, 8, pa3);
#undef PK4
}

struct AttnDesc { const f16* Q; const f16* K; const f16* V; int pq, pk, pv; f16* O; };

template <int DQK, bool MLA, int DRY = 0>
__device__ __forceinline__ void attn_unit(const AttnDesc& A, int b, int qb, LAS unsigned char* lds,
                                          const float* gq  , const float* cosd, const float* sind,
                                          const f16* part, const float* partl, int bh, const float* gout  , const int tid_in) {
    constexpr int NQF = DQK / 16;
    int tid = tid_in; asm volatile("" : "+v"(tid));
    const int lane = tid & 63, r32 = lane & 31, hi = lane >> 5; const int wid = __builtin_amdgcn_readfirstlane(tid >> 6);
    const size_t rowbase = (size_t)b * SEQ;
    const int q0 = qb * 256, qrow = q0 + wid * 32 + r32;
    LAS float* wsf = (LAS float*)(lds + AT_WS) + wid * 64;
    h8 qr[NQF];
    {
        const f16* qp = A.Q + (rowbase + qrow) * A.pq + hi * 8;
#pragma unroll
        for (int d0 = 0; d0 < NQF; ++d0) qr[d0] = *(const h8*)(qp + d0 * 16);
        if constexpr (MLA) {
            float ss = 0.f;
#pragma unroll
            for (int d0 = 0; d0 < NQF; ++d0)
#pragma unroll
                for (int j = 0; j < 8; ++j) { const float x = (float)qr[d0][j]; ss += x * x; }
            ss = swap_add(ss);
            const float rs = __builtin_amdgcn_rsqf(ss * (1.0f / 96.0f) + EPS) * (0.10206207261596575f * LOG2E);
#pragma unroll
            for (int d0 = 0; d0 < 4; ++d0) { float y[8];
#pragma unroll
                for (int j = 0; j < 8; ++j) y[j] = (float)qr[d0][j] * rs * gq[16 * d0 + 8 * hi + j];
                u32x4 w; w.x = pkh(y[0], y[1]); w.y = pkh(y[2], y[3]); w.z = pkh(y[4], y[5]); w.w = pkh(y[6], y[7]); qr[d0] = __builtin_bit_cast(h8, w); }
            { const float* cp = cosd + (rowbase + qrow) * 16 + 8 * hi; const float* sp = sind + (rowbase + qrow) * 16 + 8 * hi; float y1[8], y2[8];
#pragma unroll
              for (int j = 0; j < 8; ++j) { const float x1 = (float)qr[4][j] * rs * gq[64 + 8 * hi + j], x2 = (float)qr[5][j] * rs * gq[80 + 8 * hi + j], c = cp[j], sn = sp[j];
                  y1[j] = x1 * c - x2 * sn; y2[j] = x2 * c + x1 * sn; }
              u32x4 w; w.x = pkh(y1[0], y1[1]); w.y = pkh(y1[2], y1[3]); w.z = pkh(y1[4], y1[5]); w.w = pkh(y1[6], y1[7]); qr[4] = __builtin_bit_cast(h8, w);
              w.x = pkh(y2[0], y2[1]); w.y = pkh(y2[2], y2[3]); w.z = pkh(y2[4], y2[5]); w.w = pkh(y2[6], y2[7]); qr[5] = __builtin_bit_cast(h8, w); }
        }
    }
    u32x4 ppre[3][4]; float lpre[3];
    if constexpr (!MLA) {
        const int nsl = qb < 3 ? qb : 3; const int qs = q0 + wid * 32 + (lane >> 1);
#pragma unroll
        for (int sl = 0; sl < 3; ++sl) {
            if (sl < nsl) { const size_t pi = (size_t)(sl * 16 + bh) * 8192 + qs; lpre[sl] = partl[pi]; const f16* pp = part + pi * 64 + 32 * (lane & 1);
#pragma unroll
                for (int i = 0; i < 4; ++i) ppre[sl][i] = *(const u32x4*)(pp + 8 * i); }
            else { lpre[sl] = 0.f;
#pragma unroll
                for (int i = 0; i < 4; ++i) ppre[sl][i] = (u32x4){0u, 0u, 0u, 0u}; }
        }
    }
    const int T0 = MLA ? 0 : 4 * qb, NT = MLA ? 4 * (qb + 1) : 4;
    const int skey = tid >> 3, sch = tid & 7, skey2 = (tid >> 2) & 63, sch2 = 8 + (tid & 3);
    const unsigned kgo = (unsigned)(((rowbase + skey) * A.pk + sch * 8) * 2), kgo2 = (unsigned)(((rowbase + skey2) * A.pk + sch2 * 8) * 2), vgo = (unsigned)(((rowbase + skey) * A.pv + sch * 8) * 2);
    const char* Kbp = (const char*)A.K; const char* Vbp = (const char*)A.V; const unsigned kts = 128u * A.pk, vts = 128u * A.pv;
    const int kw = skey * 256 + ((sch ^ (skey & 15)) << 4), kw2 = skey2 * 256 + ((sch2 ^ (skey2 & 15)) << 4), vw = v_st64(skey, sch * 8);
    u32x4 skA, sk2A, svA, skB, sk2B, svB;
#define LD_K(S_, t) do { sk##S_ = *(const u32x4*)(Kbp + (kgo + (unsigned)(t) * kts)); if (DQK == 96 && tid < 256) sk2##S_ = *(const u32x4*)(Kbp + (kgo2 + (unsigned)(t) * kts)); } while (0)
#define LD_V(S_, t) do { sv##S_ = *(const u32x4*)(Vbp + (vgo + (unsigned)(t) * vts)); } while (0)
#define WR_K(S_, bf) do { *(LAS u32x4*)(lds + AT_K + (bf) * 16384 + kw) = sk##S_; if (DQK == 96 && tid < 256) *(LAS u32x4*)(lds + AT_K + (bf) * 16384 + kw2) = sk2##S_; } while (0)
#define WR_V(S_, bf) do { *(LAS u32x4*)(lds + AT_V + (bf) * 8192 + vw) = sv##S_; } while (0)
    float l_reg = 0.f; f32x16 o[2]; o[0] = f32x16{}; o[1] = f32x16{};
    const LAS unsigned char* vrd = lds + AT_V + v_rd_base(lane);
    const unsigned vra = (unsigned)(uintptr_t)vrd;
    const int lastrow = q0 + wid * 32 + 31, firstrow = q0 + wid * 32;
#define ACT(t) (64 * (T0 + (t)) <= lastrow)
#define QK(P0, P1, cur) do { P0 = f32x16{}; P1 = f32x16{}; \
        const LAS unsigned char* kt = lds + AT_K + (cur) * 16384 + r32 * 256; \
        _Pragma("unroll") \
        for (int d0 = 0; d0 < NQF; ++d0) { \
            const int off = ((2 * d0 + hi) ^ (r32 & 15)) << 4; \
            const h8 k0 = *(const LAS h8*)(kt + off), k1 = *(const LAS h8*)(kt + off + 8192); \
            P0 = __builtin_amdgcn_mfma_f32_32x32x16_f16(k0, qr[d0], P0, 0, 0, 0); \
            P1 = __builtin_amdgcn_mfma_f32_32x32x16_f16(k1, qr[d0], P1, 0, 0, 0); \
        } } while (0)
#define SOFTPV(P0, P1, t, cur) do { \
        const int kb = 64 * (T0 + (t)); \
        if (kb + 63 > firstrow) {                             \
            const int dq = qrow - kb - 4 * hi; \
            _Pragma("unroll") \
            for (int r = 0; r < 16; ++r) { const int c = (r & 3) + 8 * (r >> 2); if (c > dq) P0[r] = -INFINITY; if (c + 32 > dq) P1[r] = -INFINITY; } \
        } \
          \
        float ps = 0.f; \
        _Pragma("unroll") \
        for (int r = 0; r < 16; ++r) { P0[r] = __builtin_amdgcn_exp2f(P0[r]); P1[r] = __builtin_amdgcn_exp2f(P1[r]); ps += P0[r] + P1[r]; } \
        l_reg += ps; \
        s16x8 pa0, pa1, pa2, pa3; pack_pb(P0, P1, pa0, pa1, pa2, pa3); \
        const LAS unsigned char* vb = vrd + (cur) * 8192; \
        _Pragma("unroll") \
        for (int d0 = 0; d0 < 2; ++d0) { \
            const s16x4 l0 = vtr(vb + d0 * 512), h0 = vtr(vb + d0 * 512 + 1024), l1 = vtr(vb + d0 * 512 + 2048), h1 = vtr(vb + d0 * 512 + 3072); \
            const s16x4 l2 = vtr(vb + d0 * 512 + 4096), h2_ = vtr(vb + d0 * 512 + 5120), l3 = vtr(vb + d0 * 512 + 6144), h3 = vtr(vb + d0 * 512 + 7168); \
            o[d0] = __builtin_amdgcn_mfma_f32_32x32x16_bf16(pa0, mk8s(l0, h0), o[d0], 0, 0, 0); \
            o[d0] = __builtin_amdgcn_mfma_f32_32x32x16_bf16(pa1, mk8s(l1, h1), o[d0], 0, 0, 0); \
            o[d0] = __builtin_amdgcn_mfma_f32_32x32x16_bf16(pa2, mk8s(l2, h2_), o[d0], 0, 0, 0); \
            o[d0] = __builtin_amdgcn_mfma_f32_32x32x16_bf16(pa3, mk8s(l3, h3), o[d0], 0, 0, 0); \
        } } while (0)
#define SBAR_() __builtin_amdgcn_sched_barrier(0)
#define MASKT(PX0, PX1, t) do { const int dq = qrow - 64 * (T0 + (t)) - 4 * hi;        \
        _Pragma("unroll") \
        for (int r = 0; r < 16; ++r) { const int c = (r & 3) + 8 * (r >> 2); if (c > dq) PX0[r] = -INFINITY; if (c + 32 > dq) PX1[r] = -INFINITY; } } while (0)
#define TRA(dst, a_, off_) asm volatile("ds_read_b64_tr_b16 %0, %1 offset:%2" : "=&v"(dst) : "v"(a_), "i"(off_) : "memory")
#define VRD8A(dst, vaddr, d0_) do { TRA(dst[0], vaddr, (d0_) * 512); TRA(dst[1], vaddr, (d0_) * 512 + 1024); TRA(dst[2], vaddr, (d0_) * 512 + 2048); TRA(dst[3], vaddr, (d0_) * 512 + 3072); \
        TRA(dst[4], vaddr, (d0_) * 512 + 4096); TRA(dst[5], vaddr, (d0_) * 512 + 5120); TRA(dst[6], vaddr, (d0_) * 512 + 6144); TRA(dst[7], vaddr, (d0_) * 512 + 7168); } while (0)
#define LGKM0() do { asm volatile("s_waitcnt lgkmcnt(0)" ::: "memory"); SBAR_(); } while (0)
#define VRD8(dst, vb_, d0_) do { dst[0] = vtr((vb_) + (d0_) * 512); dst[1] = vtr((vb_) + (d0_) * 512 + 1024); dst[2] = vtr((vb_) + (d0_) * 512 + 2048); dst[3] = vtr((vb_) + (d0_) * 512 + 3072); \
        dst[4] = vtr((vb_) + (d0_) * 512 + 4096); dst[5] = vtr((vb_) + (d0_) * 512 + 5120); dst[6] = vtr((vb_) + (d0_) * 512 + 6144); dst[7] = vtr((vb_) + (d0_) * 512 + 7168); } while (0)
#define PV4(acc, vf) do { acc = __builtin_amdgcn_mfma_f32_32x32x16_bf16(pa0, mk8s(vf[0], vf[1]), acc, 0, 0, 0); acc = __builtin_amdgcn_mfma_f32_32x32x16_bf16(pa1, mk8s(vf[2], vf[3]), acc, 0, 0, 0); \
        acc = __builtin_amdgcn_mfma_f32_32x32x16_bf16(pa2, mk8s(vf[4], vf[5]), acc, 0, 0, 0); acc = __builtin_amdgcn_mfma_f32_32x32x16_bf16(pa3, mk8s(vf[6], vf[7]), acc, 0, 0, 0); } while (0)
#define MKPA(W, B_, OUT) do { auto r0_ = __builtin_amdgcn_permlane32_swap(W[B_], W[B_ + 2], false, false); auto r1_ = __builtin_amdgcn_permlane32_swap(W[B_ + 1], W[B_ + 3], false, false); \
        u32x4 w_ = {r0_[0], r1_[0], r0_[1], r1_[1]}; OUT = __builtin_bit_cast(s16x8, w_); } while (0)
#define PVT(W0, W1, VS, VF0) do { \
        s16x8 pa0, pa1, pa2, pa3; MKPA(W0, 0, pa0); MKPA(W0, 4, pa1); MKPA(W1, 0, pa2); MKPA(W1, 4, pa3); \
        const unsigned va2 = vra + (VS) * 8192; s16x4 vf1[8]; \
        SBAR_(); \
        LGKM0();                                     \
        VRD8A(vf1, va2, 1); \
        PV4(o[0], VF0); \
        SBAR_(); \
        LGKM0(); \
        PV4(o[1], vf1); \
        SBAR_(); } while (0)
#define FUSED(PX0, PX1, PY0, PY1, t, KS, VS, MASK) do { \
        if (DRY == 1) break; \
        if (DRY == 2) { const LAS unsigned char* kt = lds + AT_K + (KS) * 16384 + r32 * 256; const LAS unsigned char* vb1 = vrd + (VS) * 8192; \
            _Pragma("unroll") for (int d0 = 0; d0 < NQF; ++d0) { const int off = ((2 * d0 + hi) ^ (r32 & 15)) << 4; h8 a_ = *(const LAS h8*)(kt + off), b_ = *(const LAS h8*)(kt + off + 8192); asm volatile("" :: "v"(a_), "v"(b_)); } \
            s16x4 vfa[8], vfb[8]; VRD8(vfa, vb1, 0); VRD8(vfb, vb1, 1); _Pragma("unroll") for (int i_ = 0; i_ < 8; ++i_) asm volatile("" :: "v"(vfa[i_]), "v"(vfb[i_])); break; } \
        if (MASK) MASKT(PX0, PX1, t); \
        float ps = 0.f; unsigned wp0[8], wp1[8]; \
        const LAS unsigned char* kt = lds + AT_K + (KS) * 16384 + r32 * 256; \
        const unsigned va1 = vra + (VS) * 8192; \
        h8 kf[2][2]; s16x4 vf0[8]; \
        { const int off = ((0 + hi) ^ (r32 & 15)) << 4; kf[0][0] = *(const LAS h8*)(kt + off); kf[0][1] = *(const LAS h8*)(kt + off + 8192); } \
        SBAR_(); \
        _Pragma("unroll") \
        for (int d0 = 0; d0 < NQF; ++d0) { \
            if (d0 + 1 < NQF) { const int off = ((2 * (d0 + 1) + hi) ^ (r32 & 15)) << 4; kf[(d0 + 1) & 1][0] = *(const LAS h8*)(kt + off); kf[(d0 + 1) & 1][1] = *(const LAS h8*)(kt + off + 8192); } \
            if (d0 == 0) { PY0 = __builtin_amdgcn_mfma_f32_32x32x16_f16(kf[0][0], qr[0], f32x16{}, 0, 0, 0); PY1 = __builtin_amdgcn_mfma_f32_32x32x16_f16(kf[0][1], qr[0], f32x16{}, 0, 0, 0); } \
            else { PY0 = __builtin_amdgcn_mfma_f32_32x32x16_f16(kf[d0 & 1][0], qr[d0], PY0, 0, 0, 0); PY1 = __builtin_amdgcn_mfma_f32_32x32x16_f16(kf[d0 & 1][1], qr[d0], PY1, 0, 0, 0); } \
            if (d0 + 1 == NQF) { SBAR_(); VRD8A(vf0, va1, 0); }            \
            _Pragma("unroll") \
            for (int i = 0; i < 8; ++i) if (i >= (8 * d0) / NQF && i < (8 * (d0 + 1)) / NQF) { \
                const float e0 = __builtin_amdgcn_exp2f(PX0[2 * i]), e1 = __builtin_amdgcn_exp2f(PX0[2 * i + 1]), e2 = __builtin_amdgcn_exp2f(PX1[2 * i]), e3 = __builtin_amdgcn_exp2f(PX1[2 * i + 1]); \
                ps += (e0 + e1) + (e2 + e3); wp0[i] = pkb(e0, e1); wp1[i] = pkb(e2, e3); } \
            SBAR_(); \
        } \
        l_reg += ps; \
        PVT(wp0, wp1, VS, vf0); } while (0)
#define LASTT(PX0, PX1, t, VS) do { if (DRY) break; MASKT(PX0, PX1, t); float ps = 0.f; unsigned wp0[8], wp1[8]; s16x4 vf0[8]; VRD8A(vf0, vra + (VS) * 8192, 0); \
        _Pragma("unroll") \
        for (int i = 0; i < 8; ++i) { const float e0 = __builtin_amdgcn_exp2f(PX0[2 * i]), e1 = __builtin_amdgcn_exp2f(PX0[2 * i + 1]), e2 = __builtin_amdgcn_exp2f(PX1[2 * i]), e3 = __builtin_amdgcn_exp2f(PX1[2 * i + 1]); \
            ps += (e0 + e1) + (e2 + e3); wp0[i] = pkb(e0, e1); wp1[i] = pkb(e2, e3); } \
        l_reg += ps; PVT(wp0, wp1, VS, vf0); } while (0)
    if constexpr (!MLA) {
        LD_K(A, T0); LD_V(A, T0); WR_K(A, 0); WR_V(A, 0); __syncthreads();
#pragma unroll
        for (int t = 0; t < 4; ++t) {
            if (t + 1 < 4) { LD_K(B, T0 + t + 1); LD_V(B, T0 + t + 1); }
            if (wid >= 2 * t) {
                f32x16 p0, p1; QK(p0, p1, t & 1);
                LASTT(p0, p1, t, t & 1);
            }
            if (t + 1 < 4) { WR_K(B, (t + 1) & 1); WR_V(B, (t + 1) & 1); }
            __syncthreads();
        }
    } else {
    f32x16 pA0, pA1, pB0, pB1;
    unsigned kdo0, kdo1, vdo;
#define DMA_OFFS(ln) do { const int key0 = 8 * wid + ((ln) >> 4), key1 = key0 + 4; int c0 = ((ln) & 15) ^ (key0 & 15), c1 = ((ln) & 15) ^ (key1 & 15); if (c0 >= 12) c0 = 0; if (c1 >= 12) c1 = 0;     \
      kdo0 = (unsigned)(((rowbase + key0) * A.pk + 8 * c0) * 2); kdo1 = (unsigned)(((rowbase + key1) * A.pk + 8 * c1) * 2); \
      const int kk = 8 * wid + (((ln) & 31) >> 2), vkey = (kk & ~0xC) | ((kk & 4) << 1) | ((kk & 8) >> 1); \
      vdo = (unsigned)(((rowbase + vkey) * A.pv + 32 * ((ln) >> 5) + 8 * ((ln) & 3)) * 2); } while (0)
    DMA_OFFS(lane);
#define GLDS(src, dstoff) __builtin_amdgcn_global_load_lds((const unsigned*)(src), (LAS unsigned*)(lds + (dstoff)), 16, 0, 0)
#define DMA_K(t) do { const int sl_ = ((t) & 3) * 16384 + wid * 2048; GLDS(Kbp + (kdo0 + (unsigned)(t) * kts), AT_K + sl_); GLDS(Kbp + (kdo1 + (unsigned)(t) * kts), AT_K + sl_ + 1024); } while (0)
#define DMA_V(t) do { GLDS(Vbp + (vdo + (unsigned)(t) * vts), AT_V + ((t) & 3) * 8192 + wid * 1024); } while (0)
#define WAITBAR(N) do { asm volatile("s_waitcnt vmcnt(" #N ") lgkmcnt(0)" ::: "memory"); __builtin_amdgcn_s_barrier(); asm volatile("" ::: "memory"); } while (0)
    DMA_K(0); DMA_V(0); DMA_K(1); DMA_V(1); DMA_K(2);
    WAITBAR(0);
    if (!DRY) QK(pA0, pA1, 0);
    const int tb = NT - 4;
#pragma unroll 1
    for (int t = 0; t < tb; t += 2) {
        DMA_K(t + 3); DMA_V(t + 2); SBAR_();
        FUSED(pA0, pA1, pB0, pB1, t, (t + 1) & 3, t & 3, false); SBAR_();
        WAITBAR(3);
        DMA_K(t + 4); DMA_V(t + 3); SBAR_();
        FUSED(pB0, pB1, pA0, pA1, t + 1, (t + 2) & 3, (t + 1) & 3, false); SBAR_();
        WAITBAR(3);
    }
    {
    int r32_ = r32, hi_ = hi, qrow_ = qrow; asm volatile("" : "+v"(r32_), "+v"(hi_), "+v"(qrow_));
    const int r32 = r32_, hi = hi_, qrow = qrow_;
    { int ln2 = lane; asm volatile("" : "+v"(ln2)); DMA_OFFS(ln2); }
    DMA_K(tb + 3); DMA_V(tb + 2); SBAR_();
    FUSED(pA0, pA1, pB0, pB1, tb, 1, 0, true); SBAR_();
    WAITBAR(3);
    DMA_V(tb + 3); SBAR_();
    FUSED(pB0, pB1, pA0, pA1, tb + 1, 2, 1, true); SBAR_();
    WAITBAR(1);
    FUSED(pA0, pA1, pB0, pB1, tb + 2, 3, 2, true); SBAR_();
    WAITBAR(0);
    LASTT(pB0, pB1, tb + 3, 3);
    __syncthreads();
    }
#undef WAITBAR
#undef DMA_V
#undef DMA_K
#undef GLDS
#undef DMA_OFFS
    }
#undef LASTT
#undef FUSED
#undef PVT
#undef MKPA
#undef PV4
#undef VRD8
#undef LGKM0
#undef VRD8A
#undef TRA
#undef MASKT
#undef SBAR_
#undef SOFTPV
#undef QK
#undef ACT
#undef LD_K
#undef LD_V
#undef WR_K
#undef WR_V
    if (DRY) { __syncthreads(); return; }
    l_reg = swap_add(l_reg);
    if (hi == 0) wsf[32 + r32] = l_reg;
    LDS_WAIT();
    LAS float* stg = (LAS float*)(lds + AT_OST + wid * 8704);
#pragma unroll
    for (int r = 0; r < 16; ++r) { const int qq = crow(r, hi); stg[qq * 68 + r32] = o[0][r]; stg[qq * 68 + 32 + r32] = o[1][r]; }
    LDS_WAIT();
    {
        const int qq = lane >> 1, half = lane & 1; const LAS float* sp = stg + qq * 68 + 32 * half;
        f32x4 v[8]; float ss = 0.f; float ltot = wsf[32 + qq];
#pragma unroll
        for (int i = 0; i < 8; ++i) v[i] = *(const LAS f32x4*)(sp + 4 * i);
        if constexpr (!MLA) {
#pragma unroll
            for (int sl = 0; sl < 3; ++sl) { const float ls = lpre[sl];
#pragma unroll
                for (int i = 0; i < 4; ++i) { const u32x4 w = ppre[sl][i]; const f32x2 a = unpkh(w.x), bb = unpkh(w.y), c = unpkh(w.z), d = unpkh(w.w);
                    v[2 * i] += (f32x4){a[0], a[1], bb[0], bb[1]} * ls; v[2 * i + 1] += (f32x4){c[0], c[1], d[0], d[1]} * ls; }
                ltot += ls; }
        }
        const float rl = 1.0f / ltot;
#pragma unroll
        for (int i = 0; i < 8; ++i) { v[i] = v[i] * rl; ss += (v[i][0] * v[i][0] + v[i][1] * v[i][1]) + (v[i][2] * v[i][2] + v[i][3] * v[i][3]); }
        ss += __int_as_float(__builtin_amdgcn_ds_bpermute((lane ^ 1) << 2, __float_as_int(ss)));
        const float rs = __builtin_amdgcn_rsqf(ss * (1.0f / 64.0f) + EPS);
        unsigned char* dst = (unsigned char*)A.O + (rowbase + q0 + wid * 32 + qq) * DM + 32 * half;
        float mx = F8MAX; asm volatile("" : "+s"(mx));
#pragma unroll
        for (int i = 0; i < 4; i += 2) { u32x4 w;
#pragma unroll
            for (int j = 0; j < 2; ++j) { const f32x4 g0 = *(const f32x4*)(gout + 32 * half + 8 * (i + j)), g1 = *(const f32x4*)(gout + 32 * half + 8 * (i + j) + 4);
                const f32x4 a = v[2 * (i + j)] * rs * g0, c = v[2 * (i + j) + 1] * rs * g1;
                const unsigned lo = pk8c(a[0], a[1], a[2], a[3], mx), hi = pk8c(c[0], c[1], c[2], c[3], mx);
                if (j == 0) { w.x = lo; w.y = hi; } else { w.z = lo; w.w = hi; } }
            *(u32x4*)(dst + 8 * i) = w; }
    }
    LDS_WAIT();
    __syncthreads();
}

__device__ __forceinline__ void moba_select(const f16* proj, const float* ksum, unsigned* cnt, unsigned short* list, LAS unsigned char* lds, int vcu, const int tid_in) {
    int tid = tid_in; asm volatile("" : "+v"(tid));
    const int lane = tid & 63;
    const int gq = vcu * 512 + tid, bh = gq >> 13, q = gq & 8191, qb = q >> 8, b = bh >> 2, h = bh & 3;
    const int qbu = __builtin_amdgcn_readfirstlane(qb);
    const int qbmax = ((vcu * 512 + 511) & 8191) >> 8;
    LAS float* km = (LAS float*)lds;
    const float* ks = ksum + (size_t)(b * 128) * 256 + 64 * h;
    __syncthreads();
    for (int idx = tid; idx < qbmax * 64; idx += 512) { const int j = idx >> 6, d = idx & 63; const float* kp = ks + (size_t)(4 * j) * 256 + d;
        km[idx] = ((kp[0] + kp[256]) + (kp[512] + kp[768])) * (1.0f / 256.0f); }
    LDS_WAIT(); __syncthreads();
    float qf[64];
    { const f16* qp = proj + ((size_t)b * SEQ + q) * NPROJ + PC_AQ + 64 * h;
#pragma unroll
      for (int i = 0; i < 8; ++i) { const u32x4 w = *(const u32x4*)(qp + 8 * i); const f32x2 a = unpkh(w.x), bb = unpkh(w.y), c = unpkh(w.z), d = unpkh(w.w);
          qf[8 * i] = a[0]; qf[8 * i + 1] = a[1]; qf[8 * i + 2] = bb[0]; qf[8 * i + 3] = bb[1]; qf[8 * i + 4] = c[0]; qf[8 * i + 5] = c[1]; qf[8 * i + 6] = d[0]; qf[8 * i + 7] = d[1]; } }
    float v1 = -INFINITY, v2 = -INFINITY, v3 = -INFINITY; int i1 = -1, i2 = -1, i3 = -1;
    for (int j = 0; j < qbu; ++j) {
        float g = 0.f;
#pragma unroll
        for (int i = 0; i < 16; ++i) { const f32x4 kv = *(const LAS f32x4*)(km + j * 64 + 4 * i); g += qf[4 * i] * kv[0] + qf[4 * i + 1] * kv[1] + qf[4 * i + 2] * kv[2] + qf[4 * i + 3] * kv[3]; }
        if (g > v1) { v3 = v2; i3 = i2; v2 = v1; i2 = i1; v1 = g; i1 = j; }
        else if (g > v2) { v3 = v2; i3 = i2; v2 = g; i2 = j; }
        else if (g > v3) { v3 = g; i3 = j; }
    }
    unsigned mycnt = 0u; int ps1 = 0, ps2 = 0, ps3 = 0;
    for (int j = 0; j < qbu; ++j) {
        const bool mine = (i1 == j) | (i2 == j) | (i3 == j);
        const unsigned long long m = __ballot(mine);
        if (lane == j) mycnt = (unsigned)__popcll(m);
        const int pf = __popcll(m & ((1ull << lane) - 1ull));
        if (i1 == j) ps1 = pf; if (i2 == j) ps2 = pf; if (i3 == j) ps3 = pf;
    }
    unsigned base = 0u;
    if (lane < qbu && mycnt) base = atomicAdd(&cnt[bh * 32 + lane], mycnt);
    const unsigned b1 = __shfl(base, i1 < 0 ? 0 : i1), b2 = __shfl(base, i2 < 0 ? 0 : i2), b3 = __shfl(base, i3 < 0 ? 0 : i3);
    if (i1 >= 0) list[(size_t)(bh * 31 + i1) * 8192 + b1 + ps1] = (unsigned short)(q);
    if (i2 >= 0) list[(size_t)(bh * 31 + i2) * 8192 + b2 + ps2] = (unsigned short)(q | (1 << 13));
    if (i3 >= 0) list[(size_t)(bh * 31 + i3) * 8192 + b3 + ps3] = (unsigned short)(q | (2 << 13));
}

__device__ __forceinline__ void moba_sparse(const f16* proj, const unsigned* cnt, const unsigned short* list, f16* part, float* partl, LAS unsigned char* lds, int vcu, const int tid_in) {
    constexpr int SK = 0, SV = 32768, SST = 65536, SWS = 135168, SPRE = 137216;
    int tid = tid_in; asm volatile("" : "+v"(tid));
    const int lane = tid & 63, r32 = lane & 31, hi = lane >> 5; const int wid = __builtin_amdgcn_readfirstlane(tid >> 6);
    LAS int* pre = (LAS int*)(lds + SPRE); LAS int* wtot = pre + 520;
    __syncthreads();
    constexpr int SW = 8;
    int mytk = (tid < 496) ? (int)((cnt[(tid / 31) * 32 + tid % 31] + 31u) >> 5) + SW : 0;
    int inc = mytk;
#pragma unroll
    for (int o = 1; o < 64; o <<= 1) { const int u = __shfl_up(inc, o); if (lane >= o) inc += u; }
    if (lane == 63) wtot[wid] = inc;
    LDS_WAIT(); __syncthreads();
    { int off = 0; for (int w = 0; w < wid; ++w) off += wtot[w]; inc += off; }
    pre[tid + 1] = inc; if (tid == 0) pre[0] = 0;
    LDS_WAIT(); __syncthreads();
    const int W = pre[496]; const int t0 = (int)(((long)W * vcu) >> 8), t1 = (int)(((long)W * (vcu + 1)) >> 8);
    { const unsigned long long bm = __ballot(tid < 496 && inc <= t0); if (lane == 0) wtot[8 + wid] = (int)__popcll(bm); }
    LDS_WAIT(); __syncthreads();
    int ifirst = 0;
#pragma unroll
    for (int w = 0; w < 8; ++w) ifirst += wtot[8 + w];
    LAS float* wsf = (LAS float*)(lds + SWS) + wid * 64; LAS float* stg = (LAS float*)(lds + SST + wid * 8704);
    for (int i = ifirst; i < 496; ++i) {
        const int p0i = pre[i] + SW, p1i = pre[i + 1];
        if (pre[i] >= t1) break;
        const int lo = p0i > t0 ? p0i : t0, hi_ = p1i < t1 ? p1i : t1;
        if (lo >= hi_) continue;
        const int bh = i / 31, j = i - bh * 31, b = bh >> 2, h = bh & 3; const int n = (int)cnt[bh * 32 + j];
        {
            const f16* kg = proj + ((size_t)b * SEQ + 256 * j) * NPROJ + PC_AK + 64 * h; const f16* vg = proj + ((size_t)b * SEQ + 256 * j) * NPROJ + PC_AV + 64 * h;
#pragma unroll
            for (int c = 0; c < 4; ++c) { const int idx = tid + 512 * c, key = idx >> 3, ch = idx & 7;
                const u32x4 kv = *(const u32x4*)(kg + (size_t)key * NPROJ + 8 * ch), vv = *(const u32x4*)(vg + (size_t)key * NPROJ + 8 * ch);
                *(LAS u32x4*)(lds + SK + rm_off(key, ch)) = kv; *(LAS u32x4*)(lds + SV + (key >> 6) * 8192 + v_st64(key & 63, 8 * ch)) = vv; }
        }
        LDS_WAIT(); __syncthreads();
        const f16* qbase = proj + ((size_t)b * SEQ) * NPROJ + PC_AQ + 64 * h + 8 * hi;
        const int tau0 = lo - p0i + wid, tauE = hi_ - p0i;
        unsigned e_n = 0u; h8 qn[4];
        if (tau0 < tauE) { const int ei = 32 * tau0 + r32; e_n = list[(size_t)i * 8192 + (ei < n ? ei : 32 * tau0)];
            const f16* qp = qbase + (size_t)(e_n & 8191) * NPROJ;
#pragma unroll
            for (int d0 = 0; d0 < 4; ++d0) qn[d0] = *(const h8*)(qp + 16 * d0); }
        for (int tau = tau0; tau < tauE; tau += 8) {
            const unsigned e = e_n; h8 qr[4];
#pragma unroll
            for (int d0 = 0; d0 < 4; ++d0) qr[d0] = qn[d0];
            if (tau + 8 < tauE) { const int ei = 32 * (tau + 8) + r32; e_n = list[(size_t)i * 8192 + (ei < n ? ei : 32 * (tau + 8))];
                const f16* qp = qbase + (size_t)(e_n & 8191) * NPROJ;
#pragma unroll
                for (int d0 = 0; d0 < 4; ++d0) qn[d0] = *(const h8*)(qp + 16 * d0); }
            float l_reg = 0.f; f32x16 o[2]; o[0] = f32x16{}; o[1] = f32x16{};
#pragma unroll 1
            for (int kt = 0; kt < 4; ++kt) {
                f32x16 p0 = f32x16{}, p1 = f32x16{};
#pragma unroll
                for (int d0 = 0; d0 < 4; ++d0) {
                    const LAS unsigned char* ka = lds + SK + rm_off(64 * kt + r32, 2 * d0 + hi);
                    const h8 k0 = *(const LAS h8*)ka, k1 = *(const LAS h8*)(ka + 4096);
                    p0 = __builtin_amdgcn_mfma_f32_32x32x16_f16(k0, qr[d0], p0, 0, 0, 0);
                    p1 = __builtin_amdgcn_mfma_f32_32x32x16_f16(k1, qr[d0], p1, 0, 0, 0);
                }
                float ps = 0.f;
#pragma unroll
                for (int r = 0; r < 16; ++r) { p0[r] = __builtin_amdgcn_exp2f(p0[r]); p1[r] = __builtin_amdgcn_exp2f(p1[r]); ps += p0[r] + p1[r]; }
                l_reg += ps;
                s16x8 pa0, pa1, pa2, pa3; pack_pb(p0, p1, pa0, pa1, pa2, pa3);
                const LAS unsigned char* vb = lds + SV + kt * 8192 + v_rd_base(lane);
#pragma unroll
                for (int d0 = 0; d0 < 2; ++d0) {
                    const s16x4 l0 = vtr(vb + d0 * 512), h0 = vtr(vb + d0 * 512 + 1024), l1 = vtr(vb + d0 * 512 + 2048), h1 = vtr(vb + d0 * 512 + 3072);
                    const s16x4 l2 = vtr(vb + d0 * 512 + 4096), h2_ = vtr(vb + d0 * 512 + 5120), l3 = vtr(vb + d0 * 512 + 6144), h3 = vtr(vb + d0 * 512 + 7168);
                    o[d0] = __builtin_amdgcn_mfma_f32_32x32x16_bf16(pa0, mk8s(l0, h0), o[d0], 0, 0, 0);
                    o[d0] = __builtin_amdgcn_mfma_f32_32x32x16_bf16(pa1, mk8s(l1, h1), o[d0], 0, 0, 0);
                    o[d0] = __builtin_amdgcn_mfma_f32_32x32x16_bf16(pa2, mk8s(l2, h2_), o[d0], 0, 0, 0);
                    o[d0] = __builtin_amdgcn_mfma_f32_32x32x16_bf16(pa3, mk8s(l3, h3), o[d0], 0, 0, 0);
                }
            }
            l_reg = swap_add(l_reg);
            if (hi == 0) { wsf[r32] = l_reg; wsf[32 + r32] = __uint_as_float(e); }
#pragma unroll
            for (int r = 0; r < 16; ++r) { const int qq = crow(r, hi); stg[qq * 68 + r32] = o[0][r]; stg[qq * 68 + 32 + r32] = o[1][r]; }
            LDS_WAIT();
            {
                const int qq = lane >> 1, half = lane & 1; const LAS float* sp = stg + qq * 68 + 32 * half;
                const float lq = wsf[qq]; const unsigned eq = __float_as_uint(wsf[32 + qq]); const float rl = 1.0f / lq;
                if (32 * tau + qq < n) {
                    const size_t pi = (size_t)((eq >> 13) * 16 + bh) * 8192 + (eq & 8191);
                    f16* dst = part + pi * 64 + 32 * half;
#pragma unroll
                    for (int ii = 0; ii < 4; ++ii) { const f32x4 a = *(const LAS f32x4*)(sp + 8 * ii) * rl, c = *(const LAS f32x4*)(sp + 8 * ii + 4) * rl;
                        u32x4 w; w.x = pkh(a[0], a[1]); w.y = pkh(a[2], a[3]); w.z = pkh(c[0], c[1]); w.w = pkh(c[2], c[3]); *(u32x4*)(dst + 8 * ii) = w; }
                    if (half == 0) partl[pi] = lq;
                }
            }
            LDS_WAIT();
        }
        __syncthreads();
    }
}

constexpr int ML_ITEM = 65536;
constexpr int ML_Q = 0, ML_K = 8192, ML_V = 16384, ML_C = 32768, ML_F = 49152;
constexpr int MLF_GS = 0, MLF_BT = 64, MLF_W = 128, MLF_N = 192, MLF_SC = 256;
__device__ __forceinline__ float log_sigmoid(float x) { return fminf(x, 0.f) - log1pf(__expf(-fabsf(x))); }
__device__ __forceinline__ float silu(float y) { return y * __builtin_amdgcn_rcpf(1.0f + __expf(-y)); }

constexpr int ML_CW = 139264;
__device__ __forceinline__ void ml_load_conv(LAS unsigned char* lds, const float* cw, const float* cb, const float* gmo, int tid) {
    LAS float* d = (LAS float*)(lds + ML_CW);
    for (int i = tid; i < 3072; i += 512) d[i] = (i < 2048) ? cw[i] : (i < 2560 ? cb[i - 2048] : gmo[i - 2560]);
    LDS_WAIT(); __syncthreads();
}
template <int NCH>
__device__ __forceinline__ void conv_silu(const f16* proj, LAS const float* cw, LAS const float* cb, size_t grow, int tseq, int col0, float scale, float (&y)[NCH]) {
#pragma unroll
    for (int c = 0; c < NCH; c += 4) { const f32x4 bv = *(LAS const f32x4*)(cb + col0 + c); y[c] = bv[0]; y[c + 1] = bv[1]; y[c + 2] = bv[2]; y[c + 3] = bv[3]; }
#pragma unroll
    for (int j = 0; j < 4; ++j) {
        if (tseq - 3 + j >= 0) {
            const f16* src = proj + (grow - 3 + j) * NPROJ + col0;
#pragma unroll
            for (int q = 0; q < NCH / 8; ++q) { const u32x4 w = *(const u32x4*)(src + 8 * q); const f32x4 w0 = *(LAS const f32x4*)(cw + j * 512 + col0 + 8 * q), w1 = *(LAS const f32x4*)(cw + j * 512 + col0 + 8 * q + 4);
                const f32x2 a = unpkh(w.x), b = unpkh(w.y), c = unpkh(w.z), d = unpkh(w.w);
                y[8 * q + 0] += a[0] * w0[0]; y[8 * q + 1] += a[1] * w0[1]; y[8 * q + 2] += b[0] * w0[2]; y[8 * q + 3] += b[1] * w0[3];
                y[8 * q + 4] += c[0] * w1[0]; y[8 * q + 5] += c[1] * w1[1]; y[8 * q + 6] += d[0] * w1[2]; y[8 * q + 7] += d[1] * w1[3]; }
        }
    }
#pragma unroll
    for (int c = 0; c < NCH; ++c) y[c] = silu(y[c]) * scale;
}

struct MlArgs { float* btg; const f16* proj; const float* gates; const float* cw; const float* cb; const float* bi; const float* bf; f16* cst; float* nst; float* ba; float* mst; f16* mix; const float* gmo; };

__device__ __forceinline__ void ml_gates(const MlArgs& M, int mode, size_t grow0, int head, int bh, int j, LAS float* fl, int lane) {
    const float* gp = M.gates + (grow0 + lane) * 8;
    const float ip = gp[head] + M.bi[head], fp = gp[4 + head] + M.bf[head];
    float c = log_sigmoid(fp);
#pragma unroll
    for (int o = 1; o < 64; o <<= 1) { const float u = __shfl_up(c, o); if (lane >= o) c += u; }
    if (mode == 0) {
        const float Bt = __shfl(c, 63);
        const float lw = Bt - c + ip;
        float a = lw;
#pragma unroll
        for (int o = 1; o < 64; o <<= 1) a = fmaxf(a, __shfl_xor(a, o));
        fl[MLF_W + lane] = __expf(lw - a);
        *(f32x2*)(M.btg + ((grow0 + lane) * 4 + head) * 2) = (f32x2){c, ip - c};
        if (lane == 0) { M.ba[((size_t)bh * 128 + j) * 2] = Bt; M.ba[((size_t)bh * 128 + j) * 2 + 1] = a; }
    } else {
        fl[MLF_GS + lane] = ip - c; fl[MLF_BT + lane] = c;
    }
}

__device__ __forceinline__ void mlstm_m1(const MlArgs& M, LAS unsigned char* lds, int vcu, const int tid_in) {
    int tid = tid_in; asm volatile("" : "+v"(tid));
    const int hw = tid >> 8, th = tid & 255, lane = tid & 63, r32 = lane & 31, hi = lane >> 5; const int wq = __builtin_amdgcn_readfirstlane((tid >> 6) & 3);
    LAS unsigned char* L = lds + hw * ML_ITEM; LAS float* fl = (LAS float*)(L + ML_F);
    ml_load_conv(lds, M.cw, M.cb, M.gmo, tid);
    if (wq == 0) {
#pragma unroll
        for (int rd = 0; rd < 4; ++rd) { const int item = vcu * 8 + rd * 2 + hw, c64 = item >> 2, head = item & 3, b = c64 >> 7, j = c64 & 127;
            ml_gates(M, 0, (size_t)c64 * 64, head, b * 4 + head, j, fl + 512 + rd * 64 - MLF_W, lane); }
    }
    LDS_WAIT(); __syncthreads();
    for (int rd = 0; rd < 4; ++rd) {
        const int item = vcu * 8 + rd * 2 + hw, c64 = item >> 2, head = item & 3, b = c64 >> 7, j = c64 & 127, bh = b * 4 + head;
        const size_t grow0 = (size_t)c64 * 64;
        LAS const float* wv = fl + 512 + rd * 64;
        {
            const int s = th >> 2, part = th & 3;
            float y[16];
            conv_silu<16>(M.proj, (LAS const float*)(lds + ML_CW), (LAS const float*)(lds + ML_CW) + 2048, grow0 + s, j * 64 + s, PC_MK + 64 * head + 16 * part, 1.0f, y);
#pragma unroll
            for (int q = 0; q < 2; ++q) { u32x4 w; w.x = pkh(y[8 * q], y[8 * q + 1]); w.y = pkh(y[8 * q + 2], y[8 * q + 3]); w.z = pkh(y[8 * q + 4], y[8 * q + 5]); w.w = pkh(y[8 * q + 6], y[8 * q + 7]);
                *(LAS u32x4*)(L + ML_K + v_st64(s, 16 * part + 8 * q)) = w; }
            const float ws = wv[s];
            const f16* vp = M.proj + (grow0 + s) * NPROJ + PC_MV + 128 * head + 32 * part;
#pragma unroll
            for (int q = 0; q < 4; ++q) { const u32x4 w = *(const u32x4*)(vp + 8 * q); const f32x2 a = unpkh(w.x), bb = unpkh(w.y), c = unpkh(w.z), d = unpkh(w.w);
                u32x4 o; o.x = pkh(a[0] * ws, a[1] * ws); o.y = pkh(bb[0] * ws, bb[1] * ws); o.z = pkh(c[0] * ws, c[1] * ws); o.w = pkh(d[0] * ws, d[1] * ws);
                *(LAS u32x4*)(L + ML_V + v_st128(s, 32 * part + 8 * q)) = o; }
        }
        LDS_WAIT(); __syncthreads();
        {
            f32x16 acc[2]; acc[0] = f32x16{}; acc[1] = f32x16{};
            const LAS unsigned char* vb = L + ML_V + v_rd_base(lane) + wq * 512; const LAS unsigned char* kb = L + ML_K + v_rd_base(lane);
#pragma unroll
            for (int ks = 0; ks < 4; ++ks) {
                const h8 af = mk8(vtr(vb + ks * 4096), vtr(vb + ks * 4096 + 2048));
#pragma unroll
                for (int db = 0; db < 2; ++db) { const h8 bf_ = mk8(vtr(kb + db * 512 + ks * 2048), vtr(kb + db * 512 + ks * 2048 + 1024));
                    acc[db] = __builtin_amdgcn_mfma_f32_32x32x16_f16(bf_, af, acc[db], 0, 0, 0); }
            }
            f16* dst = M.cst + ((size_t)bh * 128 + j) * 8192 + (32 * wq + r32) * 64 + 4 * hi;
#pragma unroll
            for (int db = 0; db < 2; ++db)
#pragma unroll
                for (int g = 0; g < 4; ++g) { u32x2 w; w.x = pkh(acc[db][4 * g], acc[db][4 * g + 1]); w.y = pkh(acc[db][4 * g + 2], acc[db][4 * g + 3]); *(u32x2*)(dst + 32 * db + 8 * g) = w; }
            if (th < 64) { float s = 0.f; for (int k = 0; k < 64; ++k) s += wv[k] * (float)*(const LAS f16*)(L + ML_K + v_st64(k, th)); M.nst[((size_t)bh * 128 + j) * 64 + th] = s; }
        }
        LDS_WAIT(); __syncthreads();
    }
}

template <int STRIDE>
__device__ __forceinline__ void m2_chain(float* base, int el, const float* ba) {
    constexpr int NB = 32;
    float mp = 0.f, c = 0.f;
    float xa[NB], xb[NB];
#pragma unroll
    for (int u = 0; u < NB; ++u) xa[u] = base[u * STRIDE + el];
    for (int j0 = 0; j0 < 128; j0 += NB) {
        if (j0 + NB < 128) {
#pragma unroll
            for (int u = 0; u < NB; ++u) xb[u] = base[(j0 + NB + u) * STRIDE + el];
        }
#pragma unroll
        for (int u = 0; u < NB; ++u) {
            const float Bj = ba[2 * (j0 + u)], aj = ba[2 * (j0 + u) + 1];
            const float mn = fmaxf(Bj + mp, aj);
            const float dec = __expf(Bj + mp - mn), sc = __expf(aj - mn);
            const float xin = xa[u]; xa[u] = c;
            c = dec * c + sc * xin; mp = mn;
        }
#pragma unroll
        for (int u = 0; u < NB; ++u) base[(j0 + u) * STRIDE + el] = xa[u];
#pragma unroll
        for (int u = 0; u < NB; ++u) xa[u] = xb[u];
    }
}
__device__ __forceinline__ void m2_chain2(const unsigned* bin, unsigned* bout, int el, const float* ba, float* mst_or_null) {
    constexpr int NB = 32;
    float mp = 0.f, c0 = 0.f, c1 = 0.f;
    unsigned xa[NB], xb[NB];
#pragma unroll
    for (int u = 0; u < NB; ++u) xa[u] = bin[u * 4096 + el];
    for (int j0 = 0; j0 < 128; j0 += NB) {
        if (j0 + NB < 128) {
#pragma unroll
            for (int u = 0; u < NB; ++u) xb[u] = bin[(j0 + NB + u) * 4096 + el];
        }
#pragma unroll
        for (int u = 0; u < NB; ++u) {
            const float Bj = ba[2 * (j0 + u)], aj = ba[2 * (j0 + u) + 1];
            const float mn = fmaxf(Bj + mp, aj);
            const float dec = __expf(Bj + mp - mn), sc = __expf(aj - mn);
            const f32x2 xin = unpkh(xa[u]); xa[u] = pkh(c0, c1);
            if (mst_or_null) mst_or_null[j0 + u] = mp;
            c0 = dec * c0 + sc * xin[0]; c1 = dec * c1 + sc * xin[1]; mp = mn;
        }
#pragma unroll
        for (int u = 0; u < NB; ++u) bout[(j0 + u) * 4096 + el] = xa[u];
#pragma unroll
        for (int u = 0; u < NB; ++u) xa[u] = xb[u];
    }
}
__device__ __forceinline__ void mlstm_m2(const MlArgs& M, int vcu, int tid) {
    const int bh = vcu >> 4;
    const float* ba = M.ba + (size_t)bh * 256;
    if (tid < 256) { const int el = (vcu & 15) * 256 + tid;
        m2_chain2((const unsigned*)(M.cst + (size_t)bh * 128 * 8192), (unsigned*)(M.cst + (size_t)16 * 128 * 8192 + (size_t)bh * 128 * 8192), el, ba, el == 0 ? M.mst + bh * 128 : nullptr); }
    else if (tid < 260) { const int el = (vcu & 15) * 4 + (tid - 256);
        m2_chain<64>(M.nst + (size_t)bh * 128 * 64, el, ba); }
}

__device__ __forceinline__ void mlstm_m3(const MlArgs& M, LAS unsigned char* lds, int vcu, const int tid_in) {
    int tid = tid_in; asm volatile("" : "+v"(tid));
    const int hw = tid >> 8, th = tid & 255, lane = tid & 63, r32 = lane & 31, hi = lane >> 5; const int wq = __builtin_amdgcn_readfirstlane((tid >> 6) & 3);
    const int qh = wq & 1, vh = wq >> 1;
    LAS unsigned char* L = lds + hw * ML_ITEM; LAS float* fl = (LAS float*)(L + ML_F);
    ml_load_conv(lds, M.cw, M.cb, M.gmo, tid);
    for (int rd = 0; rd < 4; ++rd) {
        const int item = vcu * 8 + rd * 2 + hw, c64 = item >> 2, head = item & 3, b = c64 >> 7, j = c64 & 127, bh = b * 4 + head;
        const size_t grow0 = (size_t)c64 * 64;
        {
            if (th < 64) { const f32x2 bg = *(const f32x2*)(M.btg + ((grow0 + th) * 4 + head) * 2); fl[MLF_BT + th] = bg[0]; fl[MLF_GS + th] = bg[1]; }
            if (th == 64) fl[MLF_W] = M.mst[bh * 128 + j];
            const int s = th >> 2, part = th & 3;
            float y[32];
            conv_silu<32>(M.proj, (LAS const float*)(lds + ML_CW), (LAS const float*)(lds + ML_CW) + 2048, grow0 + s, j * 64 + s, (part < 2 ? PC_MQ : PC_MK) + 64 * head + 32 * (part & 1), part < 2 ? 0.125f : 1.0f, y);
            LAS unsigned char* dstt = L + (part < 2 ? ML_Q : ML_K);
#pragma unroll
            for (int q = 0; q < 4; ++q) { u32x4 w; w.x = pkh(y[8 * q], y[8 * q + 1]); w.y = pkh(y[8 * q + 2], y[8 * q + 3]); w.z = pkh(y[8 * q + 4], y[8 * q + 5]); w.w = pkh(y[8 * q + 6], y[8 * q + 7]);
                *(LAS u32x4*)(dstt + rm_off(s, 4 * (part & 1) + q)) = w; }
            const f16* vp = M.proj + (grow0 + s) * NPROJ + PC_MV + 128 * head + 32 * part;
#pragma unroll
            for (int q = 0; q < 4; ++q) *(LAS u32x4*)(L + ML_V + v_st128(s, 32 * part + 8 * q)) = *(const u32x4*)(vp + 8 * q);
            const int v = th >> 1, half = th & 1;
            const f16* cp = M.cst + (size_t)16 * 128 * 8192 + ((size_t)bh * 128 + j) * 8192 + v * 64 + 32 * half;
#pragma unroll
            for (int q = 0; q < 4; ++q) *(LAS u32x4*)(L + ML_C + rm_off(v, 4 * half + q)) = *(const u32x4*)(cp + 8 * q);
            if (th < 64) fl[MLF_N + th] = M.nst[((size_t)bh * 128 + j) * 64 + th];
        }
        LDS_WAIT(); __syncthreads();
        f32x16 o[2]; o[0] = f32x16{}; o[1] = f32x16{};
        float scl;
        u32x4 ogw[4];
        { const f16* op = M.proj + (grow0 + (th >> 2)) * NPROJ + PC_MO + 128 * head + 32 * (th & 3);
#pragma unroll
          for (int i = 0; i < 4; ++i) ogw[i] = *(const u32x4*)(op + 8 * i); }
        {
            const int t = 32 * qh + r32;
            const float mprev = fl[MLF_W];
            h8 qf[4];
#pragma unroll
            for (int d0 = 0; d0 < 4; ++d0) qf[d0] = *(const LAS h8*)(L + ML_Q + rm_off(t, 2 * d0 + hi));
            f32x16 p0 = f32x16{}, p1 = f32x16{};
#pragma unroll
            for (int d0 = 0; d0 < 4; ++d0) { const h8 k0 = *(const LAS h8*)(L + ML_K + rm_off(r32, 2 * d0 + hi));
                p0 = __builtin_amdgcn_mfma_f32_32x32x16_f16(k0, qf[d0], p0, 0, 0, 0); }
            if (qh == 1) {
#pragma unroll
                for (int d0 = 0; d0 < 4; ++d0) { const h8 k1 = *(const LAS h8*)(L + ML_K + rm_off(32 + r32, 2 * d0 + hi));
                    p1 = __builtin_amdgcn_mfma_f32_32x32x16_f16(k1, qf[d0], p1, 0, 0, 0); }
            }
            const float btt = fl[MLF_BT + t];
            float ld0[16], ld1[16]; float mi = -INFINITY;
#pragma unroll
            for (int r = 0; r < 16; ++r) { const int s0 = crow(r, hi), s1 = s0 + 32;
                ld0[r] = (s0 <= t) ? btt + fl[MLF_GS + s0] : -INFINITY; ld1[r] = (s1 <= t) ? btt + fl[MLF_GS + s1] : -INFINITY;
                mi = fmaxf(mi, fmaxf(ld0[r], ld1[r])); }
            mi = swap_max(mi);
            const float linter = btt + mprev, mt = fmaxf(linter, mi), inter = __expf(linter - mt);
            float rs = 0.f;
#pragma unroll
            for (int r = 0; r < 16; ++r) { p0[r] *= __expf(ld0[r] - mt); p1[r] *= __expf(ld1[r] - mt); rs += p0[r] + p1[r]; }
            rs = swap_add(rs);
            float qn = 0.f;
#pragma unroll
            for (int d0 = 0; d0 < 4; ++d0)
#pragma unroll
                for (int jj = 0; jj < 8; ++jj) qn += (float)qf[d0][jj] * fl[MLF_N + 16 * d0 + 8 * hi + jj];
            qn = swap_add(qn);
            const float den = rs + inter * qn;
            scl = __builtin_amdgcn_rcpf(fmaxf(fabsf(den), __expf(-mt)));
            h8 pa0, pa1, pa2, pa3; pack_p(p0, p1, pa0, pa1, pa2, pa3);
            h8 qa[4];
#pragma unroll
            for (int d0 = 0; d0 < 4; ++d0) { u32x4 w; w.x = pkh((float)qf[d0][0] * inter, (float)qf[d0][1] * inter); w.y = pkh((float)qf[d0][2] * inter, (float)qf[d0][3] * inter);
                w.z = pkh((float)qf[d0][4] * inter, (float)qf[d0][5] * inter); w.w = pkh((float)qf[d0][6] * inter, (float)qf[d0][7] * inter); qa[d0] = __builtin_bit_cast(h8, w); }
            const LAS unsigned char* vb = L + ML_V + v_rd_base(lane);
#pragma unroll
            for (int vbk = 0; vbk < 2; ++vbk) {
                const int cb = 2 * vh + vbk;
#pragma unroll
                for (int d0 = 0; d0 < 4; ++d0) { const h8 cf = *(const LAS h8*)(L + ML_C + rm_off(32 * cb + r32, 2 * d0 + hi));
                    o[vbk] = __builtin_amdgcn_mfma_f32_32x32x16_f16(qa[d0], cf, o[vbk], 0, 0, 0); }
                const LAS unsigned char* vc = vb + cb * 512;
                o[vbk] = __builtin_amdgcn_mfma_f32_32x32x16_f16(pa0, mk8(vtr(vc), vtr(vc + 2048)), o[vbk], 0, 0, 0);
                o[vbk] = __builtin_amdgcn_mfma_f32_32x32x16_f16(pa1, mk8(vtr(vc + 4096), vtr(vc + 6144)), o[vbk], 0, 0, 0);
                o[vbk] = __builtin_amdgcn_mfma_f32_32x32x16_f16(pa2, mk8(vtr(vc + 8192), vtr(vc + 10240)), o[vbk], 0, 0, 0);
                o[vbk] = __builtin_amdgcn_mfma_f32_32x32x16_f16(pa3, mk8(vtr(vc + 12288), vtr(vc + 14336)), o[vbk], 0, 0, 0);
            }
            if (hi == 0) fl[MLF_SC + wq * 64 + r32] = scl;
        }
        LDS_WAIT(); __syncthreads();
        {
            LAS float* stg = (LAS float*)L;
#pragma unroll
            for (int r = 0; r < 16; ++r) { const int tl = crow(r, hi); const float sc = fl[MLF_SC + wq * 64 + tl]; const int t = 32 * qh + tl;
                stg[t * 132 + 32 * (2 * vh) + r32] = o[0][r] * sc; stg[t * 132 + 32 * (2 * vh + 1) + r32] = o[1][r] * sc; }
        }
        LDS_WAIT(); __syncthreads();
        {
            const int t = th >> 2, part = th & 3; const LAS float* sp = (const LAS float*)L + t * 132 + 32 * part;
            f32x4 v[8]; float ss = 0.f;
#pragma unroll
            for (int i = 0; i < 8; ++i) { v[i] = *(const LAS f32x4*)(sp + 4 * i); ss += (v[i][0] * v[i][0] + v[i][1] * v[i][1]) + (v[i][2] * v[i][2] + v[i][3] * v[i][3]); }
            ss += __shfl_xor(ss, 1); ss += __shfl_xor(ss, 2);
            const float rsn = __builtin_amdgcn_rsqf(ss * (1.0f / 128.0f) + EPS);
            LAS const float* gp = (LAS const float*)(lds + ML_CW) + 2560 + 128 * head + 32 * part;
            unsigned char* dst = (unsigned char*)M.mix + (grow0 + t) * DM + 128 * head + 32 * part;
            u32x4 w8;
#pragma unroll
            for (int i = 0; i < 4; ++i) { const u32x4 ow = ogw[i]; const f32x2 a = unpkh(ow.x), bb = unpkh(ow.y), c = unpkh(ow.z), d = unpkh(ow.w);
                const f32x4 g0 = *(LAS const f32x4*)(gp + 8 * i), g1 = *(LAS const f32x4*)(gp + 8 * i + 4);
                const float og[8] = {a[0], a[1], bb[0], bb[1], c[0], c[1], d[0], d[1]};
                float r8[8];
#pragma unroll
                for (int e = 0; e < 4; ++e) { r8[e] = v[2 * i][e] * rsn * g0[e] * __builtin_amdgcn_rcpf(1.0f + __expf(-og[e])); r8[4 + e] = v[2 * i + 1][e] * rsn * g1[e] * __builtin_amdgcn_rcpf(1.0f + __expf(-og[4 + e])); }
                const unsigned lo = pk8(r8[0], r8[1], r8[2], r8[3]), hi = pk8(r8[4], r8[5], r8[6], r8[7]);
                if ((i & 1) == 0) { w8.x = lo; w8.y = hi; } else { w8.z = lo; w8.w = hi; *(u32x4*)(dst + 8 * (i - 1)) = w8; } }
        }
        LDS_WAIT(); __syncthreads();
    }
}

__device__ __forceinline__ void mla_kprep(f16* proj, f16* lkv, const float* gk, const float* cosd, const float* sind, int gw, int ngw, int lane) {
    const int head = lane >> 4, jl = lane & 15;
    const f32x4 g = *(const f32x4*)(gk + 4 * jl); const float g1 = gk[64 + jl], g2 = gk[80 + jl];
    constexpr int R = 4;
    for (int row0 = gw * R; row0 < T; row0 += ngw * R) {
        u32x2 nw[R]; float k1[R], k2[R], c[R], sn[R];
#pragma unroll
        for (int r = 0; r < R; ++r) { const size_t row = (size_t)(row0 + r);
            nw[r] = *(const u32x2*)(lkv + row * LQP + 128 * head + 4 * jl);
            k1[r] = (float)proj[row * NPROJ + PC_KPE + jl]; k2[r] = (float)proj[row * NPROJ + PC_KPE + 16 + jl];
            c[r] = cosd[row * 16 + jl]; sn[r] = sind[row * 16 + jl]; }
#pragma unroll
        for (int r = 0; r < R; ++r) { const size_t row = (size_t)(row0 + r);
            const f32x2 n0 = unpkh(nw[r].x), n1 = unpkh(nw[r].y);
            float ss = n0[0] * n0[0] + n0[1] * n0[1] + n1[0] * n1[0] + n1[1] * n1[1] + k1[r] * k1[r] + k2[r] * k2[r];
            ss += __shfl_xor(ss, 1); ss += __shfl_xor(ss, 2); ss += __shfl_xor(ss, 4); ss += __shfl_xor(ss, 8);
            const float rs = __builtin_amdgcn_rsqf(ss * (1.0f / 96.0f) + EPS);
            u32x2 w; w.x = pkh(n0[0] * rs * g[0], n0[1] * rs * g[1]); w.y = pkh(n1[0] * rs * g[2], n1[1] * rs * g[3]);
            f16* dst = proj + row * NPROJ + PC_LK + 96 * head;
            *(u32x2*)(dst + 4 * jl) = w;
            const float x1 = k1[r] * rs * g1, x2 = k2[r] * rs * g2;
            dst[64 + jl] = (f16)(x1 * c[r] - x2 * sn[r]); dst[80 + jl] = (f16)(x2 * c[r] + x1 * sn[r]); }
    }
}

constexpr int NPHASE = 1 + 7 * DEPTH;

__global__ void __launch_bounds__(512, 2) hybrid_fwd(Params p) {
    extern __shared__ __attribute__((aligned(16))) unsigned char lds_raw[];
    LAS unsigned char* lds = (LAS unsigned char*)lds_raw;
    volatile LAS unsigned* MISC = (volatile LAS unsigned*)(lds + MISC_OFF);
    const int wave0 = __builtin_amdgcn_readfirstlane((int)threadIdx.x >> 6);
    for (int u = threadIdx.x; u < (LDS_BYTES - MISC_OFF) / 4; u += 512) ((LAS unsigned*)(lds + MISC_OFF))[u] = 0u;
    __syncthreads();
    if (!MK_PER_PHASE) (void)xcd_barrier_post((unsigned*)(p.ws + WS_CTL) + 4096, MISC + 8);
#define GRID_BAR() do { if (!MK_PER_PHASE) { XcdBarrier bar_; bar_.bar = (unsigned*)(ws + WS_CTL) + 4096; bar_.x = xb_xcc_id(); bar_.st = (volatile LAS unsigned*)(lds + MISC_OFF) + 8; xcd_barrier(bar_); } } while (0)

    if (p.ph_lo == 0) { const int ph = 0;
        int G = gridDim.x, bx = blockIdx.x; asm volatile("" : "+s"(G), "+s"(bx));
        const int vcu = (G % 8 == 0) ? (bx % 8) * (G / 8) + bx / 8 : bx;
        unsigned long long wsi = (unsigned long long)p.ws; asm volatile("" : "+s"(wsi));
        unsigned char* ws = (unsigned char*)(GAS unsigned char*)wsi;
#define TIDNOW() ({ int t_; asm volatile("v_mbcnt_lo_u32_b32 %0, -1, 0\n\tv_mbcnt_hi_u32_b32 %0, -1, %0" : "=v"(t_)); t_ + wave0 * 64; })
#define LANENOW() (TIDNOW() & 63)
        const int wave = wave0;
#define ssqa ((float*)(ws + WS_SM + SM_SSQA))
#define ssqb ((float*)(ws + WS_SM + SM_SSQB))
#define cqp ((float*)(ws + WS_SM + SM_CQP))
#define ckvp ((float*)(ws + WS_SM + SM_CKVP))
#define gates ((float*)(ws + WS_SM + SM_GATES))
#define ksum ((float*)(ws + WS_SM + SM_KSUM))
#define ba ((float*)(ws + WS_SM + SM_BA))
#define mst ((float*)(ws + WS_SM + SM_MST))
#define nst ((float*)(ws + WS_SM + SM_NST))
#define cosp ((float*)(ws + WS_SM + SM_COSP))
#define sinp ((float*)(ws + WS_SM + SM_SINP))
#define cosd ((float*)(ws + WS_SM + SM_COSD))
#define sind ((float*)(ws + WS_SM + SM_SIND))
#define x16 ((f16*)(ws + WS_X16))
#define cst ((f16*)(ws + WS_X16))
#define mix ((f16*)(ws + WS_MIX))
#define proj ((f16*)(ws + WS_PROJ))
#define lq ((f16*)(ws + WS_LQ))
#define lkv ((f16*)(ws + WS_LKV))
#define hb ((f16*)(ws + WS_H))
#define part ((f16*)(ws + WS_PART))
#define partl ((float*)(ws + WS_PARTL))
#define list ((unsigned short*)(ws + WS_LIST))
        const int gw = vcu * 8 + wave, ngw = G * 8;
        if (ph == 0) { for (int rep0 = 0; rep0 < DBL_P0; ++rep0) {
            LAS float* scr = (LAS float*)(lds + wave * 16384);
            constexpr int I_IN = 16 * 96, I_UQ = 6 * 16, I_UKV = 4 * 16, I_OUT = 16 * 32, I_UP = 16 * 128, I_DOWN = 64 * 32, I_L = I_UQ + I_UKV + I_OUT + I_DOWN;
            unsigned* ctl = (unsigned*)(ws + WS_CTL);
            static_assert(DEPTH * DM == 2048, "one w_in row per wave of the 256 x 8 grid");
            {
                const int r = gw, l = r / DM, k = r % DM; const f32x4* wr_ = (const f32x4*)(p.in[2] + ((size_t)l * DM + k) * DIN); float m = 0.f; f32x4 v[12];
#pragma unroll
                for (int i = 0; i < 12; ++i) { const int c = LANENOW() + 64 * i; v[i] = (f32x4){0.f, 0.f, 0.f, 0.f}; if (c < DIN / 4) v[i] = wr_[c]; }
#pragma unroll
                for (int i = 0; i < 12; ++i) m = fmaxf(fmaxf(m, fmaxf(fabsf(v[i][0]), fabsf(v[i][1]))), fmaxf(fabsf(v[i][2]), fabsf(v[i][3])));
                m = wave_max(m * fabsf(p.in[7][l * DM + k]));
                float m2 = 0.f; { const f32x4* ur_ = (const f32x4*)(p.in[21] + ((size_t)l * DM + k) * DFF) + LANENOW(); f32x4 u[16];
#pragma unroll
                    for (int i = 0; i < 16; ++i) u[i] = ur_[64 * i];
#pragma unroll
                    for (int i = 0; i < 16; ++i) m2 = fmaxf(fmaxf(m2, fmaxf(fabsf(u[i][0]), fabsf(u[i][1]))), fmaxf(fabsf(u[i][2]), fabsf(u[i][3]))); }
                m2 = wave_max(m2 * fabsf(p.in[20][l * DM + k]));
                LAS float* red = (LAS float*)(lds + 8 * 16384);
                if (LANENOW() == 0) { red[wave] = m; red[8 + wave] = m2; }
                LDS_WAIT(); __syncthreads();
                if (TIDNOW() == 0) { float mm = red[0], mm2 = red[8];
#pragma unroll
                    for (int i = 1; i < 8; ++i) { mm = fmaxf(mm, red[i]); mm2 = fmaxf(mm2, red[8 + i]); }
                    (void)__hip_atomic_fetch_max(ctl + CTL_WMAX + l, __float_as_uint(mm), __ATOMIC_RELAXED, __HIP_MEMORY_SCOPE_AGENT);
                    (void)__hip_atomic_fetch_max(ctl + CTL_WMAX + 2 + l, __float_as_uint(mm2), __ATOMIC_RELAXED, __HIP_MEMORY_SCOPE_AGENT);
                    (void)__hip_atomic_fetch_add(ctl + CTL_WDONE, 1u, __ATOMIC_RELEASE, __HIP_MEMORY_SCOPE_AGENT); }
            }
            if (wave < 4) {
                const int* pos = (const int*)p.in[1];
                for (int row = vcu * 4 + wave; row < T; row += G * 4) {
                    const f32x4* xr = (const f32x4*)(p.in[0] + (size_t)row * DM) + LANENOW(); f32x4 v[4]; float s = 0.f, m = 0.f;
#pragma unroll
                    for (int jx = 0; jx < 4; ++jx) { v[jx] = xr[64 * jx]; s += (v[jx][0] * v[jx][0] + v[jx][1] * v[jx][1]) + (v[jx][2] * v[jx][2] + v[jx][3] * v[jx][3]);
                        m = fmaxf(fmaxf(m, fmaxf(fabsf(v[jx][0]), fabsf(v[jx][1]))), fmaxf(fabsf(v[jx][2]), fabsf(v[jx][3]))); }
                    {
                        const int k = LANENOW(); const float ps = (float)pos[row];
                        if (k < 8) { const float f = powf(500000.0f, -(float)(2 * k) / 16.0f); float sn, cs; sincosf(ps * f, &sn, &cs); cosp[(size_t)row * 8 + k] = cs; sinp[(size_t)row * 8 + k] = sn; }
                        else if (k < 24) { const int kk = k - 8; const float f = powf(10000.0f, -(float)(2 * kk) / 32.0f); float sn, cs; sincosf(ps * f, &sn, &cs); cosd[(size_t)row * 16 + kk] = cs; sind[(size_t)row * 16 + kk] = sn; }
                    }
                    s = wave_sum(s); m = wave_max(m);
                    u32x2* o8 = (u32x2*)(x16 + (size_t)row * DM) + LANENOW();
#pragma unroll
                    for (int jx = 0; jx < 4; ++jx) { u32x2 w; w.x = pkh(v[jx][0], v[jx][1]); w.y = pkh(v[jx][2], v[jx][3]); o8[64 * jx] = w; }
                    if (LANENOW() < 16) ssqa[(size_t)row * 16 + LANENOW()] = (LANENOW() == 0) ? s : 0.f;
                    const float q = m > 0.f ? 127.0f / m : 0.f;
                    unsigned* oi = (unsigned*)(ws + WS_X8I + (size_t)row * DM) + LANENOW();
#pragma unroll
                    for (int jx = 0; jx < 4; ++jx) oi[64 * jx] = pki8(v[jx][0] * q, v[jx][1] * q, v[jx][2] * q, v[jx][3] * q);
                    if (LANENOW() == 0) ((float*)(ws + WS_SM + SM_XS))[row] = m * (1.0f / 127.0f);
                }
            } else {
                const int gwb = vcu * 4 + (wave - 4), ngwb = G * 4;
                for (int it = gwb; it < DEPTH * I_L; it += ngwb) {
                    const int l = it / I_L; int r = it % I_L; unsigned char* wl = ws + WS_W + (size_t)l * W_LAYER;
                    if (r < I_UQ) { transpose_item(p.in[14] + (size_t)l * 384 * 384, 384, 384, 512, 2, p.in[12] + l * 384, (f16*)(wl + WO_UQ), scr, r, LANENOW()); continue; } r -= I_UQ;
                    if (r < I_UKV) { transpose_item(p.in[15] + (size_t)l * 256 * 512, 256, 512, 512, 0, p.in[13] + l * 256, (f16*)(wl + WO_UKV), scr, r, LANENOW()); continue; } r -= I_UKV;
                    if (r < I_OUT) { transpose_item(p.in[19] + (size_t)l * DM * DM, DM, DM, DM, 0, nullptr, (f16*)(wl + WO_OUT), scr, r, LANENOW(), F8_WOUT); continue; } r -= I_OUT;
                    transpose_item(p.in[22] + (size_t)l * DFF * DM, DFF, DM, DM, 0, nullptr, (f16*)(wl + WO_DOWN), scr, r, LANENOW(), F8_WDOWN);
                }
                if (LANENOW() == 0) { unsigned sp_ = 0; while (__hip_atomic_load(ctl + CTL_WDONE, __ATOMIC_ACQUIRE, __HIP_MEMORY_SCOPE_AGENT) < (unsigned)G) { __builtin_amdgcn_s_sleep(2); if (++sp_ > (1u << 24)) break; } }
                __builtin_amdgcn_fence(__ATOMIC_ACQUIRE, "agent");
                for (int it = gwb; it < DEPTH * I_IN; it += ngwb) {
                    const int l = it / I_IN, r = it % I_IN; unsigned char* wl = ws + WS_W + (size_t)l * W_LAYER;
                    const float wmax = __uint_as_float(__hip_atomic_load(ctl + CTL_WMAX + l, __ATOMIC_RELAXED, __HIP_MEMORY_SCOPE_AGENT));
                    transpose_item(p.in[2] + (size_t)l * DM * DIN, DM, DIN, NPROJ, 1, p.in[7] + l * DM, (f16*)(wl + WO_IN), scr, r, LANENOW(), wmax > 0.f ? 127.0f / wmax : 0.f, 1);
                    const int n0 = 32 * (r % 96);
                    if (n0 >= 1536 && n0 < 2048) transpose_item(p.in[2] + (size_t)l * DM * DIN, DM, DIN, NPROJ, 1, p.in[7] + l * DM, (f16*)(wl + WO_IN + 3 * MiB) - (size_t)1536 * DM, scr, r, LANENOW());
                }
                for (int it = gwb; it < DEPTH * I_UP; it += ngwb) {
                    const int l = it / I_UP, r = it % I_UP; unsigned char* wl = ws + WS_W + (size_t)l * W_LAYER;
                    const float wmax = __uint_as_float(__hip_atomic_load(ctl + CTL_WMAX + 2 + l, __ATOMIC_RELAXED, __HIP_MEMORY_SCOPE_AGENT));
                    transpose_item(p.in[21] + (size_t)l * DM * DFF, DM, DFF, DFF, 0, p.in[20] + l * DM, (f16*)(wl + WO_UP), scr, r, LANENOW(), wmax > 0.f ? 127.0f / wmax : 0.f, 1);
                }
            }
            }
        }
        if (1 < p.ph_hi) { for (int rep = 0; rep < DBL_BAR; ++rep) GRID_BAR(); }
    }
    for (int ph = p.ph_lo > 1 ? p.ph_lo : 1; ph < p.ph_hi; ++ph) {
        int G = gridDim.x, bx = blockIdx.x; asm volatile("" : "+s"(G), "+s"(bx));
        const int vcu = (G % 8 == 0) ? (bx % 8) * (G / 8) + bx / 8 : bx;
        unsigned long long wsi = (unsigned long long)p.ws; asm volatile("" : "+s"(wsi));
        unsigned char* ws = (unsigned char*)(GAS unsigned char*)wsi;
        const int wave = wave0;
        const int gw = vcu * 8 + wave, ngw = G * 8;
        {
            const int l = (ph - 1) / 7, sub = (ph - 1) % 7; unsigned char* wl = ws + WS_W + (size_t)l * W_LAYER;
            MlArgs ML{(float*)(ws + WS_SM + SM_BTG), proj, gates, p.in[3] + (size_t)l * 4 * 512, p.in[4] + l * 512, p.in[5] + l * 4, p.in[6] + l * 4, cst, nst, ba, mst, mix, p.in[8] + l * 512};
            if (sub == 0) {
                EpiProj E{proj, (LAS const float*)(lds + ROWSC_OFF), cqp, ckvp, gates, ksum, cosp, sinp, p.in[9] + l * 64, p.in[10] + l * 64};
                for (int rep = 0; rep < DBL_P1; ++rep) {
                {
                    pg8::StaticOrder S; S.init(T, NPROJ - 512, G, bx, 0, 6);
                    pg8::Gemm g{(const f16*)(ws + WS_X8I), (const f16*)(wl + WO_IN), T, NPROJ - 512, DM / 2, DM / 2, DM / 2};
                    rowscale_table(lds, S, ssqa, 4, 1.0f / DM, TIDNOW(), (const float*)(ws + WS_SM + SM_XS), __uint_as_float(((const unsigned*)(ws + WS_CTL))[CTL_WMAX + l]) * (1.0f / 127.0f));
                    pg8::gemm_phase<EpiProj, true, 2>(lds, g, S, E, TIDNOW()); }
                {
                    pg8::StaticOrder S; S.init(T, 512, G, bx, 6);
                    pg8::Gemm g{x16, (const f16*)(wl + WO_IN + 3 * MiB) - (size_t)6 * 256 * DM, T, 512, DM, DM, DM};
                    rowscale_table(lds, S, ssqa, 4, 1.0f / DM, TIDNOW());
                    pg8::gemm_phase<EpiProj, true>(lds, g, S, E, TIDNOW()); }
                }
            } else if (sub == 1) {
                for (int rep = 0; rep < DBL_P2G; ++rep) {
                { pg8::Gemm g{proj + PC_CQ, (const f16*)(wl + WO_UQ), T, 512, 384, NPROJ, 384}; pg8::StaticOrder S; S.init(T, 512, G, bx);
                  rowscale_table(lds, S, cqp, 2, 1.0f / 384.0f, TIDNOW());
                  EpiScale<0> E{lq, LQP, (LAS const float*)(lds + ROWSC_OFF), 0}; pg8::gemm_phase<EpiScale<0>, true>(lds, g, S, E, TIDNOW()); }
                { pg8::Gemm g{proj + PC_CKV, (const f16*)(wl + WO_UKV), T, 512, 256, NPROJ, 256}; pg8::StaticOrder S; S.init(T, 512, G, bx);
                  rowscale_table(lds, S, ckvp, 1, 1.0f / 256.0f, TIDNOW());
                  EpiScale<0> E{lkv, LQP, (LAS const float*)(lds + ROWSC_OFF), 1}; pg8::gemm_phase<EpiScale<0>, true>(lds, g, S, E, TIDNOW()); } }
                __syncthreads();
                for (int rep = 0; rep < DBL_P2; ++rep) mlstm_m1(ML, lds, vcu, TIDNOW());
                moba_select(proj, ksum, (unsigned*)(ws + WS_CTL) + CTL_CNT + l * 512, list, lds, vcu, TIDNOW());
            } else if (sub == 2) {
                for (int rep = 0; rep < DBL_KP; ++rep) mla_kprep(proj, lkv, p.in[17] + l * 96, cosd, sind, gw, ngw, LANENOW());
                mlstm_m2(ML, vcu, TIDNOW());
                for (int rep = 0; rep < DBL_MOBA; ++rep) moba_sparse(proj, (const unsigned*)(ws + WS_CTL) + CTL_CNT + l * 512, list, part, partl, lds, vcu, TIDNOW());
            } else if (sub == 3) {
                const int bh = vcu >> 4, s = vcu & 15, b = bh >> 2, h = bh & 3;
#ifdef PROBE_DRY
                { AttnDesc A{lq + 128 * h, proj + PC_LK + 96 * h, lkv + 128 * h + 64, LQP, NPROJ, LQP, (f16*)((unsigned char*)mix + 768 + 64 * h)};
                attn_unit<96, true, PROBE_DRY>(A, b, 31 - s, lds, p.in[16] + l * 96, cosd, sind, nullptr, nullptr, bh, p.in[18] + l * 256 + 64 * h, TIDNOW());
                attn_unit<96, true, PROBE_DRY>(A, b, s, lds, p.in[16] + l * 96, cosd, sind, nullptr, nullptr, bh, p.in[18] + l * 256 + 64 * h, TIDNOW()); }
#endif
                for (int rep = 0; rep < DBL_MLA; ++rep) {
                AttnDesc A{lq + 128 * h, proj + PC_LK + 96 * h, lkv + 128 * h + 64, LQP, NPROJ, LQP, (f16*)((unsigned char*)mix + 768 + 64 * h)};
                attn_unit<96, true>(A, b, 31 - s, lds, p.in[16] + l * 96, cosd, sind, nullptr, nullptr, bh, p.in[18] + l * 256 + 64 * h, TIDNOW());
                attn_unit<96, true>(A, b, s, lds, p.in[16] + l * 96, cosd, sind, nullptr, nullptr, bh, p.in[18] + l * 256 + 64 * h, TIDNOW()); }
                for (int rep = 0; rep < DBL_OWN; ++rep) {
                AttnDesc A{proj + PC_AQ + 64 * h, proj + PC_AK + 64 * h, proj + PC_AV + 64 * h, NPROJ, NPROJ, NPROJ, (f16*)((unsigned char*)mix + 512 + 64 * h)};
                attn_unit<64, false>(A, b, 2 * s, lds, nullptr, nullptr, nullptr, part, partl, bh, p.in[11] + l * 256 + 64 * h, TIDNOW());
                attn_unit<64, false>(A, b, 2 * s + 1, lds, nullptr, nullptr, nullptr, part, partl, bh, p.in[11] + l * 256 + 64 * h, TIDNOW());
                }
                for (int rep = 0; rep < DBL_M3; ++rep) mlstm_m3(ML, lds, vcu, TIDNOW());
            } else if (sub == 4) {
                pg8::Gemm g{mix, (const f16*)(wl + WO_OUT), T, DM, DM / 2, DM / 2, DM / 2}; pg8::StaticOrder S; S.init(T, DM, G, bx);
                rowscale_table(lds, S, ssqa, 4, 1.0f / DM, TIDNOW());
                EpiRes E{l == 0 ? p.in[0] : p.out, p.out, x16, ssqb, 1, 2, 1.0f / F8_WOUT, (unsigned char*)x16, (float*)(ws + WS_SM + SM_XS2), (LAS const float*)(lds + ROWSC_OFF)};
                pg8::gemm_phase<EpiRes, true, true>(lds, g, S, E, TIDNOW());
            } else if (sub == 5) {
                pg8::Gemm g{x16, (const f16*)(wl + WO_UP), T, DFF, DM / 2, DM / 2, DM / 2}; pg8::StaticOrder S; S.init(T, DFF, G, bx);
                rowscale_table(lds, S, ssqb, 4, 1.0f / DM, TIDNOW(), (const float*)(ws + WS_SM + SM_XS2), __uint_as_float(((const unsigned*)(ws + WS_CTL))[CTL_WMAX + 2 + l]) * (1.0f / 127.0f));
                EpiAct8 E{(unsigned char*)hb, DFF, (LAS const float*)(lds + ROWSC_OFF)};
                for (int rep = 0; rep < DBL_P6; ++rep) pg8::gemm_phase<EpiAct8, true, 2>(lds, g, S, E, TIDNOW());
            } else {
                pg8::Gemm g{hb, (const f16*)(wl + WO_DOWN), T, DM, DFF / 2, DFF / 2, DFF / 2}; pg8::StaticOrder S; S.init(T, DM, G, bx);
                if (l + 1 < DEPTH) rowscale_table(lds, S, ssqb, 4, 1.0f / DM, TIDNOW());
                EpiRes E{p.out, p.out, x16, ssqa, l + 1 < DEPTH ? 1 : 0, 0, 1.0f / (F8_H * F8_WDOWN), l + 1 < DEPTH ? ws + WS_X8I : nullptr, (float*)(ws + WS_SM + SM_XS), (LAS const float*)(lds + ROWSC_OFF)};
                pg8::gemm_phase<EpiRes, true, true>(lds, g, S, E, TIDNOW());
            }
        }
        if (ph + 1 < p.ph_hi) { for (int rep = 0; rep < DBL_BAR; ++rep) GRID_BAR(); }
    }
}

extern "C" void kernel_launch(void* const* d_in, const int* in_sizes, int n_in, void* d_out, int out_size, void* d_ws, size_t ws_size, hipStream_t stream) {
    static int grid = 0;
    if (grid == 0) {
        if (n_in != 23 || in_sizes[0] != T * DM || out_size != T * DM || ws_size < WS_END) { fprintf(stderr, "kernel_launch: shape / workspace mismatch (n_in %d, ws %zu)\n", n_in, ws_size); grid = -1; return; }
        int dev = 0, cus = 0;
        if (hipGetDevice(&dev) != hipSuccess || hipDeviceGetAttribute(&cus, hipDeviceAttributeMultiprocessorCount, dev) != hipSuccess) { grid = -1; return; }
        if (hipFuncSetAttribute((const void*)hybrid_fwd, hipFuncAttributeMaxDynamicSharedMemorySize, LDS_BYTES) != hipSuccess) { fprintf(stderr, "kernel_launch: hipFuncSetAttribute failed\n"); grid = -1; return; }
        int per_cu = 0;
        if (hipOccupancyMaxActiveBlocksPerMultiprocessor(&per_cu, (const void*)hybrid_fwd, 512, LDS_BYTES) != hipSuccess || per_cu < 1) { fprintf(stderr, "kernel_launch: occupancy query reports %d\n", per_cu); }
        (void)hipGetLastError();
        grid = cus;
        if (grid != 256) { fprintf(stderr, "kernel_launch: built for 256 CUs, found %d\n", grid); grid = -1; return; }
    }
    if (grid < 0) return;
    (void)hipMemsetAsync((char*)d_ws + WS_CTL, 0, CTL_ZERO_BYTES, stream);
    Params p{};
    for (int i = 0; i < 23; ++i) p.in[i] = (const float*)d_in[i];
    p.out = (float*)d_out; p.ws = (unsigned char*)d_ws;
#if MK_PER_PHASE
    for (int ph = 0; ph < NPHASE; ++ph) { p.ph_lo = ph; p.ph_hi = ph + 1; hipLaunchKernelGGL(hybrid_fwd, dim3(grid), dim3(512), LDS_BYTES, stream, p); }
#else
    p.ph_lo = 0; p.ph_hi = NPHASE;
    hipLaunchKernelGGL(hybrid_fwd, dim3(grid), dim3(512), LDS_BYTES, stream, p);
#endif
}
```

```cpp
#include <hip/hip_runtime.h>
#include <cstdio>
#include <cstdint>

#ifndef MK_PER_PHASE
#define MK_PER_PHASE 0
#endif
#ifndef DBL_MOBA
#define DBL_MOBA 1
#endif
#ifndef DBL_MLA
#define DBL_MLA 1
#endif
#ifndef DBL_P1
#define DBL_P1 1
#endif
#ifndef DBL_P6
#define DBL_P6 1
#endif
#ifndef DBL_M3
#define DBL_M3 1
#endif
#ifndef DBL_P2
#define DBL_P2 1
#endif
#ifndef DBL_OWN
#define DBL_OWN 1
#endif
#ifndef DBL_SEL
#define DBL_SEL 1
#endif
#ifndef DBL_P0
#define DBL_P0 1
#endif
#ifndef DBL_KP
#define DBL_KP 1
#endif
#ifndef DBL_BAR
#define DBL_BAR 1
#endif
#ifndef DBL_P2G
#define DBL_P2G 1
#endif

#define LAS __attribute__((address_space(3)))
#define GAS __attribute__((address_space(1)))
typedef _Float16 f16;
typedef _Float16 h8 __attribute__((ext_vector_type(8)));
typedef _Float16 h2 __attribute__((ext_vector_type(2)));
typedef short s16x4 __attribute__((ext_vector_type(4)));
typedef short s16x8 __attribute__((ext_vector_type(8)));
typedef float f32x2 __attribute__((ext_vector_type(2)));
typedef float f32x4 __attribute__((ext_vector_type(4)));
typedef float f32x16 __attribute__((ext_vector_type(16)));
typedef unsigned u32x2 __attribute__((ext_vector_type(2)));
typedef unsigned u32x4 __attribute__((ext_vector_type(4)));
typedef int i32x4 __attribute__((ext_vector_type(4)));
typedef int i32x8 __attribute__((ext_vector_type(8)));
typedef GAS unsigned gu32;

constexpr int NBATCH = 4, SEQ = 8192, T = NBATCH * SEQ, DM = 1024, DEPTH = 2, DIN = 2984, NPROJ = 3072, DFF = 4096;
constexpr float EPS = 1e-6f;
constexpr float LOG2E = 1.4426950408889634f;
constexpr int PC_MQ = 0, PC_MK = 256, PC_MV = 512, PC_MO = 1024, PC_AQ = 1536, PC_AK = 1792, PC_AV = 2048, PC_CQ = 2304, PC_GATE = 2688, PC_KPE = 2720, PC_CKV = 2816;
constexpr int PC_LK = PC_CQ;
constexpr int LQP = 512;

constexpr size_t MiB = 1u << 20;
constexpr size_t WS_CTL = 0, CTL_ZERO_BYTES = 65536;
constexpr size_t WS_W = 4 * MiB, W_LAYER = 25 * MiB;
constexpr size_t WO_IN = 0, WO_UQ = 6 * MiB, WO_UKV = WO_UQ + 512 * 384 * 2, WO_OUT = 7 * MiB, WO_UP = 9 * MiB, WO_DOWN = 17 * MiB;
constexpr size_t WS_SM = 54 * MiB;
constexpr size_t SM_SSQA = 0, SM_SSQB = 2 * MiB, SM_CQP = 4 * MiB, SM_CKVP = 5 * MiB, SM_GATES = 6 * MiB, SM_KSUM = 7 * MiB, SM_BA = 7 * MiB + 512 * 1024,
                 SM_MST = SM_BA + 65536, SM_NST = 8 * MiB, SM_COSP = 9 * MiB, SM_SINP = 10 * MiB, SM_COSD = 11 * MiB, SM_SIND = 13 * MiB, SM_BTG = 15 * MiB,
                 SM_XS = 5 * MiB + 512 * 1024,
                 SM_XS2 = 5 * MiB + 640 * 1024;
constexpr size_t WS_X16 = 70 * MiB;
constexpr size_t WS_X8I = 166 * MiB;
constexpr size_t WS_MIX = 134 * MiB;
constexpr size_t WS_PROJ = 198 * MiB;
constexpr size_t WS_LQ = 390 * MiB, WS_LKV = 422 * MiB;
constexpr size_t WS_RESW = 326 * MiB;
constexpr size_t WS_H = 198 * MiB;
constexpr size_t WS_PART = 454 * MiB;
constexpr size_t WS_PARTL = 502 * MiB;
constexpr size_t WS_LIST = 504 * MiB;
constexpr size_t WS_END = 512 * MiB;
constexpr int CTL_WMAX = 16, CTL_WDONE = 32;
constexpr int CTL_CNT = 8192;

constexpr int LDS_BYTES = 163840, MISC_OFF = LDS_BYTES - 512;

struct Params {
    const float* in[23];
    float* out;
    unsigned char* ws;
    int ph_lo, ph_hi;
};

#define LDS_WAIT() asm volatile("s_waitcnt lgkmcnt(0)" ::: "memory")
#define VM_WAIT() asm volatile("s_waitcnt vmcnt(0)" ::: "memory")
#define RLX_AGENT __ATOMIC_RELAXED, __HIP_MEMORY_SCOPE_AGENT

__device__ __forceinline__ int tidx() { int t = threadIdx.x; asm volatile("" : "+v"(t)); return t; }
__device__ __forceinline__ unsigned pkh(float lo, float hi) { f32x2 v = {lo, hi}; h2 h = __builtin_convertvector(v, h2); return __builtin_bit_cast(unsigned, h); }
typedef __bf16 bf2_t __attribute__((ext_vector_type(2)));
__device__ __forceinline__ unsigned pkb(float lo, float hi) { f32x2 v = {lo, hi}; bf2_t b = __builtin_convertvector(v, bf2_t); return __builtin_bit_cast(unsigned, b); }
constexpr float F8MAX = 448.0f;
__device__ __forceinline__ unsigned pk8(float a, float b, float c, float d) { int w = __builtin_amdgcn_cvt_pk_fp8_f32(a, b, 0, false); w = __builtin_amdgcn_cvt_pk_fp8_f32(c, d, w, true); return (unsigned)w; }
__device__ __forceinline__ unsigned pk8c(float a, float b, float c, float d, float mx) {
    return pk8(__builtin_fminf(__builtin_fmaxf(a, -mx), mx), __builtin_fminf(__builtin_fmaxf(b, -mx), mx), __builtin_fminf(__builtin_fmaxf(c, -mx), mx), __builtin_fminf(__builtin_fmaxf(d, -mx), mx)); }
constexpr float XQ_RANGE = 6.0f;
constexpr float F8_WUP = 32.0f, F8_WDOWN = 128.0f, F8_H = 4.0f, F8_WOUT = 64.0f;
__device__ __forceinline__ f32x2 unpkh(unsigned u) { h2 h = __builtin_bit_cast(h2, u); return __builtin_convertvector(h, f32x2); }
__device__ __forceinline__ int crow(int r, int hi) { return (r & 3) + 8 * (r >> 2) + 4 * hi; }
__device__ __forceinline__ float swap_add(float v) { auto rr = __builtin_amdgcn_permlane32_swap(__float_as_uint(v), __float_as_uint(v), false, false); return __uint_as_float(rr[0]) + __uint_as_float(rr[1]); }
__device__ __forceinline__ float swap_max(float v) { auto rr = __builtin_amdgcn_permlane32_swap(__float_as_uint(v), __float_as_uint(v), false, false); return fmaxf(__uint_as_float(rr[0]), __uint_as_float(rr[1])); }
__device__ __forceinline__ float wave_max(float v) {
#pragma unroll
    for (int o = 1; o < 64; o <<= 1) v = fmaxf(v, __shfl_xor(v, o));
    return v;
}
__device__ __forceinline__ unsigned pki8(float a, float b, float c, float d) {
    const int ia = (int)__builtin_rintf(a), ib = (int)__builtin_rintf(b), ic = (int)__builtin_rintf(c), id = (int)__builtin_rintf(d);
    return (unsigned)(ia & 255) | ((unsigned)(ib & 255) << 8) | ((unsigned)(ic & 255) << 16) | ((unsigned)id << 24);
}
__device__ __forceinline__ f32x4 tof(const f32x4& v) { return v; }
__device__ __forceinline__ f32x4 tof(const i32x4& v) { return __builtin_convertvector(v, f32x4); }
__device__ __forceinline__ float wave_sum(float v) {
#pragma unroll
    for (int o = 1; o < 64; o <<= 1) v += __shfl_xor(v, o);
    return v;
}

namespace pg8 {
constexpr int BM = 256, BK = 64, HALF = 128, HTB = HALF * BK * 2, STAGE_BYTES = 8 * HTB, NXCD = 8, WGM = 8;
__host__ __device__ __forceinline__ int lds_byte(int r, int c) { const int st = (r >> 4) * 2 + (c >> 5), rr = r & 15, cc = c & 31, ob = rr * 64 + cc * 2; return st * 1024 + (ob ^ (((ob >> 9) & 1) << 5)); }
__host__ __device__ __forceinline__ void stage_rc(int b, int& R, int& C) { const int st = b / 1024, sb = b % 1024, swz = sb ^ (((sb >> 9) & 1) << 5); R = (st >> 1) * 16 + swz / 64; C = (st & 1) * 32 + (swz % 64) / 2; }
__host__ __device__ __forceinline__ int perm32(int rho) { const int n = rho >> 4, i = rho & 15; return 8 * (i >> 2) + 4 * n + (i & 3); }
template <bool I8> struct AccSel { typedef f32x4 type; };
template <> struct AccSel<true> { typedef i32x4 type; };
struct Unit { int pm, pn, ui; };
struct Gemm { const f16* A; const f16* Bt; int M, N, K, lda, ldb; };
struct StaticOrder {
    int nM, nN, nwg, G, c, pnoff, pnskip, wgm = WGM;
    __device__ void init(int M, int N, int G_, int c_, int pnoff_ = 0, int pnskip_ = 1 << 20) { nM = M / BM; nN = N / BM; nwg = nM * nN; G = G_; c = c_; pnoff = pnoff_; pnskip = pnskip_; }
    __device__ bool next(int i, Unit& u) const {
        const long L = (long)i * G + c; if (L >= nwg) return false;
        int wgid = (int)L; { const int q = nwg / NXCD, r = nwg % NXCD, xcd = wgid % NXCD, off = wgid / NXCD; wgid = (xcd < r ? xcd * (q + 1) : r * (q + 1) + (xcd - r) * q) + off; }
        const int nig = wgm * nN, gid = wgid / nig, fm = gid * wgm, gsz = (nM - fm) < wgm ? (nM - fm) : wgm;
        u.pm = fm + ((wgid % nig) % gsz); u.pn = (wgid % nig) / gsz + pnoff; if (u.pn >= pnskip) u.pn += 2; return true;
    }
};

template <class Epi, bool ALIGN_EPI, int MODE = 0>
__device__ __forceinline__ void gemm_phase(LAS unsigned char* lds, const Gemm g, const StaticOrder& S, const Epi& E, const int tid_in) {
    constexpr bool F8 = (MODE == 1), I8 = (MODE == 2);
    int tid = tid_in; asm volatile("" : "+v"(tid));
    const int wid = __builtin_amdgcn_readfirstlane(tid >> 6), lane = tid & 63, wr = wid >> 2, wc = wid & 3, fr = lane & 15, fq = lane >> 4;
    const int K = g.K, nt = K / BK;
    unsigned voffA[2], voffB[2];
#pragma unroll
    for (int i = 0; i < 2; ++i) { int R, C; stage_rc(tid * 16 + i * 8192, R, C); const int Rb = (R & ~31) + perm32(R & 31);
        voffA[i] = (unsigned)(R * g.lda + C) * 2u; voffB[i] = (unsigned)(Rb * g.ldb + C) * 2u; }
    const size_t kstep = (size_t)(BK * 2);
    const size_t hstepA = (size_t)HALF * g.lda * 2, hstepB = (size_t)HALF * g.ldb * 2;
    const size_t tstepA = 2 * hstepA, tstepB = 2 * hstepB;
    const unsigned ldsw = (unsigned)wid * 1024u;
    const int aoff = lds_byte(wr * 64 + fr, fq * 8), boff = lds_byte(wc * 32 + fr, fq * 8);
#define PG8_SA(b, h) (((b) * 2 + (h)) * HTB)
#define PG8_SB(b, h) ((4 + (b) * 2 + (h)) * HTB)
#define PG8_STAGE(bufoff, gbase, voff) do { _Pragma("unroll") for (int _i = 0; _i < 2; ++_i) \
        __builtin_amdgcn_global_load_lds((const unsigned*)((const char*)(gbase) + (voff)[_i]), (LAS unsigned*)(lds + (bufoff) + ldsw + _i * 8192), 16, 0, 0); } while (0)
#define PG8_LDA(dst, b, h) do { _Pragma("unroll") for (int m = 0; m < 4; ++m) _Pragma("unroll") for (int k = 0; k < 2; ++k) dst[m][k] = *(const LAS h8*)(lds + PG8_SA(b, h) + aoff + m * 2048 + k * 1024); } while (0)
#define PG8_LDB(dst, b, h) do { _Pragma("unroll") for (int n = 0; n < 2; ++n) _Pragma("unroll") for (int k = 0; k < 2; ++k) dst[n][k] = *(const LAS h8*)(lds + PG8_SB(b, h) + boff + n * 2048 + k * 1024); } while (0)
#define PG8_CAT(x) __builtin_shufflevector(__builtin_bit_cast(i32x4, x[0]), __builtin_bit_cast(i32x4, x[1]), 0, 1, 2, 3, 4, 5, 6, 7)
#define PG8_MMA(ai, bj, At, Bt) do { __builtin_amdgcn_s_setprio(1); _Pragma("unroll") for (int m = 0; m < 4; ++m) _Pragma("unroll") for (int n = 0; n < 2; ++n) { \
        if constexpr (F8) { const i32x8 b8_ = PG8_CAT(Bt[n]), a8_ = PG8_CAT(At[m]); asm volatile("v_mfma_f32_16x16x128_f8f6f4 %0, %1, %2, %0" : "+v"(acc[ai][bj][m][n]) : "v"(b8_), "v"(a8_)); } \
        else if constexpr (I8) { _Pragma("unroll") for (int k = 0; k < 2; ++k) acc[ai][bj][m][n] = __builtin_amdgcn_mfma_i32_16x16x64_i8(__builtin_bit_cast(i32x4, Bt[n][k]), __builtin_bit_cast(i32x4, At[m][k]), acc[ai][bj][m][n], 0, 0, 0); } \
        else { _Pragma("unroll") for (int k = 0; k < 2; ++k) acc[ai][bj][m][n] = __builtin_amdgcn_mfma_f32_16x16x32_f16(Bt[n][k], At[m][k], acc[ai][bj][m][n], 0, 0, 0); } } \
        __builtin_amdgcn_s_setprio(0); } while (0)
#define PG8_WAIT_V(n) asm volatile("s_waitcnt vmcnt(" #n ")" ::: "memory")
#define PG8_WAIT_L(n) asm volatile("s_waitcnt lgkmcnt(" #n ")" ::: "memory")
#define PG8_BAR __builtin_amdgcn_s_barrier()
#define PG8_SCHED __builtin_amdgcn_sched_barrier(0)
    Unit cur, nxt; int ui = 0;
    if (!S.next(0, cur)) return;
    cur.ui = 0;
    typedef typename AccSel<I8>::type AccT;
    AccT acc[2][2][4][2];
#pragma unroll
    for (int a = 0; a < 2; ++a)
#pragma unroll
        for (int b = 0; b < 2; ++b)
#pragma unroll
            for (int m = 0; m < 4; ++m)
#pragma unroll
                for (int n = 0; n < 2; ++n) acc[a][b][m][n] = (AccT){0, 0, 0, 0};
    h8 At[4][2], B0[2][2], B1[2][2];
    const char* cA = (const char*)g.A + (size_t)cur.pm * tstepA; const char* cB = (const char*)g.Bt + (size_t)cur.pn * tstepB;
    PG8_STAGE(PG8_SB(0, 0), cB, voffB); PG8_STAGE(PG8_SB(0, 1), cB + hstepB, voffB); PG8_STAGE(PG8_SA(0, 0), cA, voffA); PG8_STAGE(PG8_SA(0, 1), cA + hstepA, voffA);
    if (wr == 1) PG8_BAR;
    PG8_WAIT_V(2); PG8_BAR;
    PG8_STAGE(PG8_SB(1, 0), cB + kstep, voffB); PG8_STAGE(PG8_SA(1, 0), cA + kstep, voffA); PG8_STAGE(PG8_SB(1, 1), cB + hstepB + kstep, voffB);
    PG8_WAIT_V(6); PG8_BAR;
    for (;;) {
        const bool has_next = S.next(ui + 1, nxt); nxt.ui = ui + 1;
        const char* nA = has_next ? (const char*)g.A + (size_t)nxt.pm * tstepA : cA; const char* nB = has_next ? (const char*)g.Bt + (size_t)nxt.pn * tstepB : cB;
        for (int t = 0; t < nt; t += 2) {
            const bool last = (t == nt - 2);
            const char* a1 = cA + (size_t)(t + 1) * kstep;
            const char* a2 = last ? nA : cA + (size_t)(t + 2) * kstep; const char* b2 = last ? nB : cB + (size_t)(t + 2) * kstep;
            const char* a3 = a2 + kstep; const char* b3 = b2 + kstep;
            PG8_LDB(B0, 0, 0); PG8_LDB(B1, 0, 1); PG8_SCHED; PG8_LDA(At, 0, 0); PG8_STAGE(PG8_SA(1, 1), a1 + hstepA, voffA);
            PG8_WAIT_V(8); PG8_WAIT_L(0); PG8_BAR; PG8_MMA(0, 0, At, B0); PG8_MMA(0, 1, At, B1); PG8_BAR; PG8_SCHED;
            PG8_LDA(At, 0, 1); PG8_STAGE(PG8_SB(0, 0), b2, voffB); PG8_STAGE(PG8_SB(0, 1), b2 + hstepB, voffB); PG8_STAGE(PG8_SA(0, 0), a2, voffA);
            PG8_WAIT_V(8); PG8_WAIT_L(0); PG8_BAR; PG8_MMA(1, 0, At, B0); PG8_MMA(1, 1, At, B1); PG8_BAR; PG8_SCHED;
            PG8_LDB(B0, 1, 0); PG8_LDB(B1, 1, 1); PG8_SCHED; PG8_LDA(At, 1, 0); PG8_STAGE(PG8_SA(0, 1), a2 + hstepA, voffA);
            PG8_WAIT_V(8); PG8_WAIT_L(0); PG8_BAR; PG8_MMA(0, 0, At, B0); PG8_MMA(0, 1, At, B1); PG8_BAR; PG8_SCHED;
            PG8_LDA(At, 1, 1); PG8_STAGE(PG8_SB(1, 0), b3, voffB); PG8_STAGE(PG8_SB(1, 1), b3 + hstepB, voffB); PG8_STAGE(PG8_SA(1, 0), a3, voffA);
            PG8_WAIT_V(8); PG8_WAIT_L(0); PG8_BAR; PG8_MMA(1, 0, At, B0); PG8_MMA(1, 1, At, B1); PG8_BAR; PG8_SCHED;
        }
        if constexpr (ALIGN_EPI) { if (wr == 0) PG8_BAR; }
        if constexpr (F8) asm volatile("s_nop 15\n\ts_nop 15" ::: "memory");
        { int le_; asm volatile("v_mbcnt_lo_u32_b32 %0, -1, 0\n\tv_mbcnt_hi_u32_b32 %0, -1, %0" : "=v"(le_));
          E(acc, cur, wr, wc, le_ & 15, le_ >> 4); }
        if (!has_next) break;
#pragma unroll
        for (int a = 0; a < 2; ++a)
#pragma unroll
            for (int b = 0; b < 2; ++b)
#pragma unroll
                for (int m = 0; m < 4; ++m)
#pragma unroll
                    for (int n = 0; n < 2; ++n) acc[a][b][m][n] = (AccT){0, 0, 0, 0};
        cur = nxt; cA = nA; cB = nB; ++ui;
        if constexpr (ALIGN_EPI) { if (wr == 1) PG8_BAR; }
    }
    PG8_WAIT_V(0);
    if constexpr (!ALIGN_EPI) { if (wr == 0) PG8_BAR; }
    PG8_BAR;
#undef PG8_SA
#undef PG8_SB
#undef PG8_STAGE
#undef PG8_LDA
#undef PG8_LDB
#undef PG8_MMA
#undef PG8_CAT
#undef PG8_WAIT_V
#undef PG8_WAIT_L
#undef PG8_BAR
#undef PG8_SCHED
}
}

typedef f32x4 Acc[2][2][4][2];
__device__ __forceinline__ float sum_parts(const float* p, int n4) { float s = 0.f; for (int i = 0; i < n4; ++i) { const f32x4 v = *(const f32x4*)(p + 4 * i); s += (v[0] + v[1]) + (v[2] + v[3]); } return s; }


constexpr int ROWSC_OFF = 131072;
__device__ __forceinline__ void rowscale_table(LAS unsigned char* lds, const pg8::StaticOrder& S, const float* parts, int nparts4, float inv_dim, int tid, const float* rowmul = nullptr, float smul = 1.0f) {
    LAS float* tab = (LAS float*)(lds + ROWSC_OFF);
    pg8::Unit u;
    for (int i = 0; i < 8 && S.next(i, u); ++i) {
        if (tid < 256) { const int row = u.pm * 256 + tid; float sc_ = __builtin_amdgcn_rsqf(sum_parts(parts + (size_t)row * nparts4 * 4, nparts4) * inv_dim + EPS); if (rowmul) sc_ = sc_ * rowmul[row] * smul; tab[i * 256 + tid] = sc_; }
    }
    LDS_WAIT(); __syncthreads();
}

struct EpiProj {
    f16* proj; LAS const float* rowsc; float* cqp; float* ckvp; float* gates; float* ksum;
    const float* cosp; const float* sinp; const float* gq; const float* gk;
    template <class AccArr>
    __device__ __forceinline__ void operator()(const AccArr& acc, const pg8::Unit& u, int wr, int wc, int fr, int fq) const {
        const int pn = u.pn;
        const int rbase = u.pm * 256 + wr * 64 + fr;
        const bool moba = (pn == 6 || pn == 7);
        const float qscale = (pn == 6) ? 0.125f * LOG2E : 1.0f;
        const float* gain = (pn == 6) ? gq : gk;
#pragma unroll
        for (int ai = 0; ai < 2; ++ai) {
            float ks[2][2][4];
#pragma unroll
            for (int bj = 0; bj < 2; ++bj)
#pragma unroll
                for (int n = 0; n < 2; ++n)
#pragma unroll
                    for (int e = 0; e < 4; ++e) ks[bj][n][e] = 0.f;
#pragma unroll
            for (int m = 0; m < 4; ++m) {
                const int row = rbase + ai * 128 + m * 16;
                const float rstd = rowsc[u.ui * 256 + (row & 255)];
                f32x4 v[2][2];
#pragma unroll
                for (int bj = 0; bj < 2; ++bj)
#pragma unroll
                    for (int n = 0; n < 2; ++n) v[bj][n] = tof(acc[ai][bj][m][n]) * rstd;
                if (moba) {
                    float ss = 0.f;
#pragma unroll
                    for (int bj = 0; bj < 2; ++bj)
#pragma unroll
                        for (int n = 0; n < 2; ++n) ss += (v[bj][n][0] * v[bj][n][0] + v[bj][n][1] * v[bj][n][1]) + (v[bj][n][2] * v[bj][n][2] + v[bj][n][3] * v[bj][n][3]);
                    ss += __shfl_xor(ss, 16); ss += __shfl_xor(ss, 32);
                    const float hr = __builtin_amdgcn_rsqf(ss * (1.0f / 64.0f) + EPS);
#pragma unroll
                    for (int bj = 0; bj < 2; ++bj)
#pragma unroll
                        for (int n = 0; n < 2; ++n) { const f32x4 gv = *(const f32x4*)(gain + 32 * bj + 8 * fq + 4 * n); v[bj][n] = v[bj][n] * hr * gv; }
                    {
                        f32x4 o0, o1;
#pragma unroll
                        for (int e = 0; e < 4; ++e) { o0[e] = __shfl_xor(v[0][0][e], 16); o1[e] = __shfl_xor(v[0][1][e], 16); }
                        if (fq < 2) {
                            const f32x4 c0 = *(const f32x4*)(cosp + (size_t)row * 8), c1 = *(const f32x4*)(cosp + (size_t)row * 8 + 4);
                            const f32x4 s0 = *(const f32x4*)(sinp + (size_t)row * 8), s1 = *(const f32x4*)(sinp + (size_t)row * 8 + 4);
                            const float sg = (fq == 0) ? -1.0f : 1.0f;
                            v[0][0] = v[0][0] * c0 + o0 * s0 * sg; v[0][1] = v[0][1] * c1 + o1 * s1 * sg;
                        }
                    }
                    if (pn == 7) {
#pragma unroll
                        for (int bj = 0; bj < 2; ++bj)
#pragma unroll
                            for (int n = 0; n < 2; ++n)
#pragma unroll
                                for (int e = 0; e < 4; ++e) ks[bj][n][e] += v[bj][n][e];
                    }
                    f16* dst = proj + (size_t)row * NPROJ + (pn == 6 ? PC_AQ : PC_AK) + 64 * wc + 8 * fq;
#pragma unroll
                    for (int bj = 0; bj < 2; ++bj) { u32x4 w; w.x = pkh(v[bj][0][0] * qscale, v[bj][0][1] * qscale); w.y = pkh(v[bj][0][2] * qscale, v[bj][0][3] * qscale);
                        w.z = pkh(v[bj][1][0] * qscale, v[bj][1][1] * qscale); w.w = pkh(v[bj][1][2] * qscale, v[bj][1][3] * qscale); *(u32x4*)(dst + 32 * bj) = w; }
                } else {
                    f16* dst = proj + (size_t)row * NPROJ + pn * 256 + 32 * wc + 8 * fq;
#pragma unroll
                    for (int bj = 0; bj < 2; ++bj) { u32x4 w;
                        if (pn == 8) { w.x = pkb(v[bj][0][0], v[bj][0][1]); w.y = pkb(v[bj][0][2], v[bj][0][3]); w.z = pkb(v[bj][1][0], v[bj][1][1]); w.w = pkb(v[bj][1][2], v[bj][1][3]); }
                        else { w.x = pkh(v[bj][0][0], v[bj][0][1]); w.y = pkh(v[bj][0][2], v[bj][0][3]); w.z = pkh(v[bj][1][0], v[bj][1][1]); w.w = pkh(v[bj][1][2], v[bj][1][3]); }
                        *(u32x4*)(dst + 128 * bj) = w; }
                    if (pn >= 9) {
                        float s0 = 0.f, s1 = 0.f;
#pragma unroll
                        for (int n = 0; n < 2; ++n) { s0 += (v[0][n][0] * v[0][n][0] + v[0][n][1] * v[0][n][1]) + (v[0][n][2] * v[0][n][2] + v[0][n][3] * v[0][n][3]);
                                                      s1 += (v[1][n][0] * v[1][n][0] + v[1][n][1] * v[1][n][1]) + (v[1][n][2] * v[1][n][2] + v[1][n][3] * v[1][n][3]); }
                        float s = (pn == 10) ? s0 : (s0 + s1);
                        s += __shfl_xor(s, 16); s += __shfl_xor(s, 32);
                        if (fq == 0) { if (pn == 9) cqp[(size_t)row * 8 + wc] = s; else if (pn == 10) cqp[(size_t)row * 8 + 4 + wc] = s; else ckvp[(size_t)row * 4 + wc] = s; }
                        if (pn == 10 && wc == 0 && fq == 0) { *(f32x4*)(gates + (size_t)row * 8) = v[1][0]; *(f32x4*)(gates + (size_t)row * 8 + 4) = v[1][1]; }
                    }
                }
            }
            if (pn == 7) {
#pragma unroll
                for (int bj = 0; bj < 2; ++bj)
#pragma unroll
                    for (int n = 0; n < 2; ++n)
#pragma unroll
                        for (int e = 0; e < 4; ++e) { float s = ks[bj][n][e]; s += __shfl_xor(s, 1); s += __shfl_xor(s, 2); s += __shfl_xor(s, 4); s += __shfl_xor(s, 8); ks[bj][n][e] = s; }
                if (fr == 0) {
                    float* dst = ksum + (size_t)((u.pm * 256 + ai * 128 + wr * 64) >> 6) * 256 + 64 * wc + 8 * fq;
#pragma unroll
                    for (int bj = 0; bj < 2; ++bj) { *(f32x4*)(dst + 32 * bj) = (f32x4){ks[bj][0][0], ks[bj][0][1], ks[bj][0][2], ks[bj][0][3]};
                                                     *(f32x4*)(dst + 32 * bj + 4) = (f32x4){ks[bj][1][0], ks[bj][1][1], ks[bj][1][2], ks[bj][1][3]}; }
                }
            }
        }
    }
};

template <int MODE> struct EpiScale {
    f16* O; int ldc; LAS const float* rowsc; int vbf;
    __device__ __forceinline__ void operator()(const Acc& acc, const pg8::Unit& u, int wr, int wc, int fr, int fq) const {
        const int rbase = u.pm * 256 + wr * 64 + fr; const int col0 = u.pn * 256 + 32 * wc + 8 * fq;
#pragma unroll
        for (int ai = 0; ai < 2; ++ai)
#pragma unroll
            for (int m = 0; m < 4; ++m) {
                const int row = rbase + ai * 128 + m * 16;
                float sc = rowsc[u.ui * 256 + (row & 255)];
                if (MODE == 1) sc = sc * sc;
                f16* dst = O + (size_t)row * ldc + col0;
#pragma unroll
                for (int bj = 0; bj < 2; ++bj) {
                    f32x4 v0 = acc[ai][bj][m][0], v1 = acc[ai][bj][m][1];
                    if (MODE == 1) {
#pragma unroll
                        for (int e = 0; e < 4; ++e) { const float a = fmaxf(v0[e], 0.f), b = fmaxf(v1[e], 0.f); v0[e] = a * a; v1[e] = b * b; }
                    }
                    v0 = v0 * sc; v1 = v1 * sc;
                    u32x4 w;
                    if (MODE == 0 && vbf && wc >= 2) { w.x = pkb(v0[0], v0[1]); w.y = pkb(v0[2], v0[3]); w.z = pkb(v1[0], v1[1]); w.w = pkb(v1[2], v1[3]); }
                    else { w.x = pkh(v0[0], v0[1]); w.y = pkh(v0[2], v0[3]); w.z = pkh(v1[0], v1[1]); w.w = pkh(v1[2], v1[3]); }
                    *(u32x4*)(dst + 128 * bj) = w;
                }
            }
    }
};

struct EpiAct8 {
    unsigned char* O; int ldc; LAS const float* rowsc;
    template <class AccArr>
    __device__ __forceinline__ void operator()(const AccArr& acc, const pg8::Unit& u, int wr, int wc, int fr, int fq) const {
        const int rbase = u.pm * 256 + wr * 64 + fr; const int col0 = u.pn * 256 + 32 * wc + 8 * fq;
        float lim = 21.16f, kk = 2.0f; asm volatile("" : "+s"(lim), "+s"(kk));
        static_assert(F8_H == 4.0f, "kk = sqrt(F8_H)");
#pragma unroll
        for (int ai = 0; ai < 2; ++ai)
#pragma unroll
            for (int m = 0; m < 4; ++m) {
                const int row = rbase + ai * 128 + m * 16;
                float sc = rowsc[u.ui * 256 + (row & 255)];
                sc = sc * kk;
                unsigned char* dst = O + (size_t)row * ldc + col0;
                u32x2 w[2];
#pragma unroll
                for (int bj = 0; bj < 2; ++bj) {
                    const f32x4 v0 = tof(acc[ai][bj][m][0]), v1 = tof(acc[ai][bj][m][1]);
                    const f32x2 sc2 = {sc, sc};
                    f32x2 t[4] = {(f32x2){v0[0], v0[1]} * sc2, (f32x2){v0[2], v0[3]} * sc2, (f32x2){v1[0], v1[1]} * sc2, (f32x2){v1[2], v1[3]} * sc2};
#pragma unroll
                    for (int e = 0; e < 4; ++e) { t[e][0] = __builtin_amdgcn_fmed3f(t[e][0], 0.f, lim); t[e][1] = __builtin_amdgcn_fmed3f(t[e][1], 0.f, lim); t[e] = t[e] * t[e]; }
                    w[bj].x = pk8(t[0][0], t[0][1], t[1][0], t[1][1]); w[bj].y = pk8(t[2][0], t[2][1], t[3][0], t[3][1]);
                }
                const auto rx = __builtin_amdgcn_permlane16_swap(w[0].x, w[1].x, false, false), ry = __builtin_amdgcn_permlane16_swap(w[0].y, w[1].y, false, false);
                const u32x4 o = {rx[0], ry[0], rx[1], ry[1]};
                *(u32x4*)(dst + ((fq & 1) ? 120 : 0)) = o;
            }
    }
};

struct EpiRes {
    const float* res32; const f16* res16; float* out32; f16* out16; float* ssq; int feed; float ascale;
    unsigned char* x8i; float* xs; LAS const float* rowsc;
    const unsigned char* res8; const float* rs8;
    __device__ __forceinline__ void operator()(const Acc& acc, const pg8::Unit& u, int wr, int wc, int fr, int fq) const {
        const int rbase = u.pm * 256 + wr * 64 + fr; const int col0 = u.pn * 256 + 32 * wc + 8 * fq;
#pragma unroll
        for (int ai = 0; ai < 2; ++ai)
#pragma unroll
            for (int m = 0; m < 4; ++m) {
                const int row = rbase + ai * 128 + m * 16; const size_t off = (size_t)row * DM + col0;
                float ss = 0.f; u32x2 w8[2] = {};
#pragma unroll
                for (int bj = 0; bj < 2; ++bj) {
                    f32x4 r0, r1;
                    if (res8) { const u32x2 rw = *(const u32x2*)(res8 + off + 128 * bj); const float rsc = rs8[row];
                        const unsigned ux = rw.x ^ 0x80808080u, uy = rw.y ^ 0x80808080u;
#pragma unroll
                        for (int e = 0; e < 4; ++e) { r0[e] = (float)((ux >> (8 * e)) & 255u); r1[e] = (float)((uy >> (8 * e)) & 255u); }
                        r0 = (r0 - 128.0f) * rsc; r1 = (r1 - 128.0f) * rsc; }
                    else if (res16) { const u32x4 rw = *(const u32x4*)(res16 + off + 128 * bj); const f32x2 a = unpkh(rw.x), b = unpkh(rw.y), c = unpkh(rw.z), d = unpkh(rw.w);
                        r0 = (f32x4){a[0], a[1], b[0], b[1]}; r1 = (f32x4){c[0], c[1], d[0], d[1]}; }
                    else { r0 = *(const f32x4*)(res32 + off + 128 * bj); r1 = *(const f32x4*)(res32 + off + 128 * bj + 4); }
                    const f32x4 v0 = r0 + acc[ai][bj][m][0] * ascale, v1 = r1 + acc[ai][bj][m][1] * ascale;
                    if (out32) { *(f32x4*)(out32 + off + 128 * bj) = v0; *(f32x4*)(out32 + off + 128 * bj + 4) = v1; }
                    if (out16) { u32x4 w; w.x = pkh(v0[0], v0[1]); w.y = pkh(v0[2], v0[3]); w.z = pkh(v1[0], v1[1]); w.w = pkh(v1[2], v1[3]); *(u32x4*)(out16 + off + 128 * bj) = w; }
                    if (feed) {
                    if (x8i) { const float qs = rowsc[u.ui * 256 + (row & 255)] * (127.0f / XQ_RANGE); float lim = 127.0f; asm volatile("" : "+s"(lim));
                        f32x4 a0 = v0 * qs, a1 = v1 * qs;
#pragma unroll
                        for (int e = 0; e < 4; ++e) { a0[e] = __builtin_fminf(__builtin_fmaxf(a0[e], -lim), lim); a1[e] = __builtin_fminf(__builtin_fmaxf(a1[e], -lim), lim); }
                        w8[bj].x = pki8(a0[0], a0[1], a0[2], a0[3]); w8[bj].y = pki8(a1[0], a1[1], a1[2], a1[3]); }
                    ss += (v0[0] * v0[0] + v0[1] * v0[1]) + (v0[2] * v0[2] + v0[3] * v0[3]) + (v1[0] * v1[0] + v1[1] * v1[1]) + (v1[2] * v1[2] + v1[3] * v1[3]);
                    }
                }
                if (feed) {
                if (x8i) {
                    const auto rx = __builtin_amdgcn_permlane16_swap(w8[0].x, w8[1].x, false, false), ry = __builtin_amdgcn_permlane16_swap(w8[0].y, w8[1].y, false, false);
                    const u32x4 o = {rx[0], ry[0], rx[1], ry[1]};
                    *(u32x4*)(x8i + off + ((fq & 1) ? 120 : 0)) = o; }
                ss += __shfl_xor(ss, 16); ss += __shfl_xor(ss, 32);
                if (fq == 0) ssq[(size_t)row * 16 + u.pn * 4 + wc] = ss;
                if (x8i && fq == 0 && u.pn == 0 && wc == 0) xs[row] = XQ_RANGE / (127.0f * rowsc[u.ui * 256 + (row & 255)]);
                }
            }
    }
};

#define XB_TMO      128
#define XB_XCNT(j)  (256  + 64 * (j))
#define XB_XSUB(j)  (1280 + 64 * (j))
#define XB_XGEN(j)  (2304 + 64 * (j))
#define XB_TOP      3328
#define XB_TOPGEN   3392
#define XCD_BAR_WORDS 3456
#define XB_SPIN_CAP (1u << 22)
__device__ __forceinline__ unsigned xb_ld(unsigned* p)              { return __hip_atomic_load(p, __ATOMIC_RELAXED, __HIP_MEMORY_SCOPE_AGENT); }
__device__ __forceinline__ unsigned xb_add(unsigned* p, unsigned v) { return __hip_atomic_fetch_add(p, v, __ATOMIC_RELAXED, __HIP_MEMORY_SCOPE_AGENT); }
__device__ __forceinline__ unsigned xb_xcc_id() { return (unsigned)__builtin_amdgcn_s_getreg((3 << 11) | 20) & 0xFu; }
#define XB_SPIN(cond, bar) do { unsigned _sp = 0; while (cond) { __builtin_amdgcn_s_sleep(1); \
    if ((++_sp & 255u) == 0u) { if (xb_ld(&(bar)[XB_TMO])) break; if (_sp > XB_SPIN_CAP) { atomicAdd(&(bar)[XB_TMO], 1u); break; } } } } while (0)
struct XcdBarrier { unsigned* bar; unsigned x; volatile LAS unsigned* st; };
__device__ __forceinline__ XcdBarrier xcd_barrier_post(unsigned* bar, volatile LAS unsigned* st) {
    XcdBarrier b; b.bar = bar; b.x = xb_xcc_id(); b.st = st;
    if (threadIdx.x == 0) (void)xb_add(&bar[XB_XCNT(b.x)], 1u);
    return b;
}
__device__ __forceinline__ void xcd_barrier_complete(unsigned* bar, unsigned x, unsigned& nloc, unsigned& nx) {
    const unsigned G = gridDim.x * gridDim.y * gridDim.z;
    unsigned sum, cnt, mine, sp = 0u;
    for (;;) {
        sum = 0u; cnt = 0u; mine = 0u;
#pragma unroll
        for (unsigned j = 0; j < 16; ++j) { const unsigned c = xb_ld(&bar[XB_XCNT(j)]); sum += c; cnt += (c > 0u) ? 1u : 0u; mine = (j == x) ? c : mine; }
        if (sum == G) break;
        __builtin_amdgcn_s_sleep(1);
        if ((++sp & 255u) == 0u) { if (xb_ld(&bar[XB_TMO])) break; if (sp > XB_SPIN_CAP) { atomicAdd(&bar[XB_TMO], 1u); break; } }
    }
    nloc = mine > 0u ? mine : 1u; nx = cnt > 0u ? cnt : 1u;
}
__device__ __forceinline__ void xcd_barrier(const XcdBarrier& b) {
    asm volatile("s_waitcnt vmcnt(0)" ::: "memory");
    __syncthreads();
    if (threadIdx.x == 0) {
        unsigned* bar = b.bar;
        __builtin_amdgcn_s_waitcnt(0);
        unsigned nloc = b.st[0], nx = b.st[1];
        if (nloc == 0u) { xcd_barrier_complete(bar, b.x, nloc, nx); b.st[0] = nloc; b.st[1] = nx; }
        const unsigned old = xb_add(&bar[XB_XSUB(b.x)], 1u);
        const unsigned gen = old / nloc;
        if (old + 1u == (gen + 1u) * nloc) {
            __builtin_amdgcn_fence(__ATOMIC_RELEASE, "agent");
            asm volatile("s_waitcnt vmcnt(0)" ::: "memory");
            const unsigned og = xb_add(&bar[XB_TOP], 1u);
            const unsigned tg = og / nx;
            if (og + 1u == (tg + 1u) * nx) xb_add(&bar[XB_TOPGEN], 1u);
            else XB_SPIN(xb_ld(&bar[XB_TOPGEN]) == tg, bar);
            __builtin_amdgcn_fence(__ATOMIC_ACQUIRE, "agent");
            xb_add(&bar[XB_XGEN(b.x)], 1u);
            asm volatile("s_waitcnt vmcnt(0)" ::: "memory");
        } else {
            XB_SPIN(xb_ld(&bar[XB_XGEN(b.x)]) == gen, bar);
            asm volatile("buffer_inv sc0\n\ts_waitcnt vmcnt(0)" ::: "memory");
        }
    }
    __syncthreads();
}

__device__ __forceinline__ int win_src(int n) {
    if (n < 1536) return n;
    if (n < 2048) { const int c = (n - 1536) & 255, t = (n - 1536) >> 8; const int bj = c >> 7, wc = (c >> 5) & 3, i = c & 31; return 1544 + 256 * t + 64 * wc + 32 * bj + i; }
    if (n < 2304) return 1544 + 512 + (n - 2048);
    if (n < 2688) return 2312 + (n - 2304);
    if (n < 2696) return 1536 + (n - 2688);
    if (n < 2720) return -1;
    if (n < 2752) return 2952 + (n - 2720);
    if (n < 2816) return -1;
    return 2696 + (n - 2816);
}
__device__ __forceinline__ int src_col(int kind, int n) {
    if (kind == 0) return n;
    if (kind == 1) return win_src(n);
    const int hd = n >> 7, d = n & 127; return d < 96 ? 96 * hd + d : -1;
}
__device__ __forceinline__ void transpose_item(const float* W, int K, int ldw, int N, int kind, const float* gain, f16* WT, LAS float* scr, int item, int lane, float f8s = 0.f, int qi8 = 0) {
    const int nblk = N / 32, kb = item / nblk, nb = item % nblk, k0 = 64 * kb, n0 = 32 * nb;
    const int sc0 = src_col(kind, n0), c4 = lane & 7;
#pragma unroll
    for (int i = 0; i < 8; ++i) { const int kk = 8 * i + (lane >> 3); f32x4 v = {0.f, 0.f, 0.f, 0.f};
        if (sc0 >= 0) { v = *(const f32x4*)(W + (size_t)(k0 + kk) * ldw + sc0 + 4 * c4); if (gain) v = v * gain[k0 + kk]; }
        LAS float* d = scr + kk * 33 + 4 * c4; d[0] = v[0]; d[1] = v[1]; d[2] = v[2]; d[3] = v[3]; }
    LDS_WAIT(); asm volatile("" ::: "memory");
    const int c = lane & 7;
#pragma unroll
    for (int j = 0; j < 4; ++j) { const int n = (lane >> 3) + 8 * j; const LAS float* s = scr + (8 * c) * 33 + n;
        if (qi8) { u32x2 o; o.x = pki8(s[0 * 33] * f8s, s[1 * 33] * f8s, s[2 * 33] * f8s, s[3 * 33] * f8s); o.y = pki8(s[4 * 33] * f8s, s[5 * 33] * f8s, s[6 * 33] * f8s, s[7 * 33] * f8s);
            *(u32x2*)((unsigned char*)WT + (size_t)(n0 + n) * K + k0 + 8 * c) = o; }
        else if (f8s > 0.f) { u32x2 o; o.x = pk8(s[0 * 33] * f8s, s[1 * 33] * f8s, s[2 * 33] * f8s, s[3 * 33] * f8s); o.y = pk8(s[4 * 33] * f8s, s[5 * 33] * f8s, s[6 * 33] * f8s, s[7 * 33] * f8s);
            *(u32x2*)((unsigned char*)WT + (size_t)(n0 + n) * K + k0 + 8 * c) = o; }
        else { u32x4 o; o.x = pkh(s[0 * 33], s[1 * 33]); o.y = pkh(s[2 * 33], s[3 * 33]); o.z = pkh(s[4 * 33], s[5 * 33]); o.w = pkh(s[6 * 33], s[7 * 33]);
        *(u32x4*)(WT + (size_t)(n0 + n) * K + k0 + 8 * c) = o; } }
    LDS_WAIT(); asm volatile("" ::: "memory");
}

constexpr int AT_K = 0, AT_V = 65536, AT_WS = 98304, AT_OST = 0;
__device__ __forceinline__ int rm_off(int row, int chunk) { return row * 128 + ((chunk ^ ((row >> 1) & 7)) << 4); }
__device__ __forceinline__ int v_st64(int k, int c) { const int kk = (k & ~0xC) | ((k & 4) << 1) | ((k & 8) >> 1); return ((kk >> 3) * 2 + (c >> 5)) * 512 + ((kk & 7) * 32 + (c & 31)) * 2; }
__device__ __forceinline__ int v_st128(int k, int c) { const int kk = (k & ~0xC) | ((k & 4) << 1) | ((k & 8) >> 1); return ((kk >> 3) * 4 + (c >> 5)) * 512 + ((kk & 7) * 32 + (c & 31)) * 2; }
__device__ __forceinline__ int v_rd_base(int lane) { return ((lane & 3) << 3) | (((lane >> 2) & 3) << 6) | (((lane >> 4) & 1) << 5) | (((lane >> 5) & 1) << 8); }
__device__ __forceinline__ s16x4 vtr(LAS const unsigned char* p) { return __builtin_amdgcn_ds_read_tr16_b64_v4i16((LAS s16x4*)p); }
__device__ __forceinline__ h8 mk8(s16x4 lo, s16x4 hi) { s16x8 v = {lo[0], lo[1], lo[2], lo[3], hi[0], hi[1], hi[2], hi[3]}; return __builtin_bit_cast(h8, v); }
__device__ __forceinline__ void pack_pb(const f32x16& p0, const f32x16& p1, s16x8& pa0, s16x8& pa1, s16x8& pa2, s16x8& pa3) {
#define PK4(P, B_, OUT) do { unsigned a0 = pkb(P[B_ + 0], P[B_ + 1]), a1 = pkb(P[B_ + 2], P[B_ + 3]); unsigned b0 = pkb(P[B_ + 4], P[B_ + 5]), b1 = pkb(P[B_ + 6], P[B_ + 7]); \
        auto r0 = __builtin_amdgcn_permlane32_swap(a0, b0, false, false); auto r1 = __builtin_amdgcn_permlane32_swap(a1, b1, false, false); \
        u32x4 w = {r0[0], r1[0], r0[1], r1[1]}; OUT = __builtin_bit_cast(s16x8, w); } while (0)
    PK4(p0, 0, pa0); PK4(p0, 8, pa1); PK4(p1, 0, pa2); PK4(p1, 8, pa3);
#undef PK4
}
__device__ __forceinline__ s16x8 mk8s(s16x4 lo, s16x4 hi) { s16x8 v = {lo[0], lo[1], lo[2], lo[3], hi[0], hi[1], hi[2], hi[3]}; return v; }
__device__ __forceinline__ void pack_p(const f32x16& p0, const f32x16& p1, h8& pa0, h8& pa1, h8& pa2, h8& pa3) {
#define PK4(P, B_, OUT) do { unsigned a0 = pkh(P[B_ + 0], P[B_ + 1]), a1 = pkh(P[B_ + 2], P[B_ + 3]); unsigned b0 = pkh(P[B_ + 4], P[B_ + 5]), b1 = pkh(P[B_ + 6], P[B_ + 7]); \
        auto r0 = __builtin_amdgcn_permlane32_swap(a0, b0, false, false); auto r1 = __builtin_amdgcn_permlane32_swap(a1, b1, false, false); \
        u32x4 w = {r0[0], r1[0], r0[1], r1[1]}; OUT = __builtin_bit_cast(h8, w); } while (0)
    PK4(p0, 0, pa0); PK4(p0, 8, pa1); PK4(p1, 0, pa2); PK4(p1, 8, pa3);
#undef PK4
}

struct AttnDesc { const f16* Q; const f16* K; const f16* V; int pq, pk, pv; f16* O; };

template <int DQK, bool MLA, int DRY = 0>
__device__ __forceinline__ void attn_unit(const AttnDesc& A, int b, int qb, LAS unsigned char* lds,
                                          const float* gq  , const float* cosd, const float* sind,
                                          const f16* part, const float* partl, int bh, const float* gout  , const int tid_in) {
    constexpr int NQF = DQK / 16;
    int tid = tid_in; asm volatile("" : "+v"(tid));
    const int lane = tid & 63, r32 = lane & 31, hi = lane >> 5; const int wid = __builtin_amdgcn_readfirstlane(tid >> 6);
    const size_t rowbase = (size_t)b * SEQ;
    const int q0 = qb * 256, qrow = q0 + wid * 32 + r32;
    LAS float* wsf = (LAS float*)(lds + AT_WS) + wid * 64;
    h8 qr[NQF];
    {
        const f16* qp = A.Q + (rowbase + qrow) * A.pq + hi * 8;
#pragma unroll
        for (int d0 = 0; d0 < NQF; ++d0) qr[d0] = *(const h8*)(qp + d0 * 16);
        if constexpr (MLA) {
            float ss = 0.f;
#pragma unroll
            for (int d0 = 0; d0 < NQF; ++d0)
#pragma unroll
                for (int j = 0; j < 8; ++j) { const float x = (float)qr[d0][j]; ss += x * x; }
            ss = swap_add(ss);
            const float rs = __builtin_amdgcn_rsqf(ss * (1.0f / 96.0f) + EPS) * (0.10206207261596575f * LOG2E);
#pragma unroll
            for (int d0 = 0; d0 < 4; ++d0) { float y[8];
#pragma unroll
                for (int j = 0; j < 8; ++j) y[j] = (float)qr[d0][j] * rs * gq[16 * d0 + 8 * hi + j];
                u32x4 w; w.x = pkh(y[0], y[1]); w.y = pkh(y[2], y[3]); w.z = pkh(y[4], y[5]); w.w = pkh(y[6], y[7]); qr[d0] = __builtin_bit_cast(h8, w); }
            { const float* cp = cosd + (rowbase + qrow) * 16 + 8 * hi; const float* sp = sind + (rowbase + qrow) * 16 + 8 * hi; float y1[8], y2[8];
#pragma unroll
              for (int j = 0; j < 8; ++j) { const float x1 = (float)qr[4][j] * rs * gq[64 + 8 * hi + j], x2 = (float)qr[5][j] * rs * gq[80 + 8 * hi + j], c = cp[j], sn = sp[j];
                  y1[j] = x1 * c - x2 * sn; y2[j] = x2 * c + x1 * sn; }
              u32x4 w; w.x = pkh(y1[0], y1[1]); w.y = pkh(y1[2], y1[3]); w.z = pkh(y1[4], y1[5]); w.w = pkh(y1[6], y1[7]); qr[4] = __builtin_bit_cast(h8, w);
              w.x = pkh(y2[0], y2[1]); w.y = pkh(y2[2], y2[3]); w.z = pkh(y2[4], y2[5]); w.w = pkh(y2[6], y2[7]); qr[5] = __builtin_bit_cast(h8, w); }
        }
    }
    u32x4 ppre[3][4]; float lpre[3];
    if constexpr (!MLA) {
        const int nsl = qb < 3 ? qb : 3; const int qs = q0 + wid * 32 + (lane >> 1);
#pragma unroll
        for (int sl = 0; sl < 3; ++sl) {
            if (sl < nsl) { const size_t pi = (size_t)(sl * 16 + bh) * 8192 + qs; lpre[sl] = partl[pi]; const f16* pp = part + pi * 64 + 32 * (lane & 1);
#pragma unroll
                for (int i = 0; i < 4; ++i) ppre[sl][i] = *(const u32x4*)(pp + 8 * i); }
            else { lpre[sl] = 0.f;
#pragma unroll
                for (int i = 0; i < 4; ++i) ppre[sl][i] = (u32x4){0u, 0u, 0u, 0u}; }
        }
    }
    const int T0 = MLA ? 0 : 4 * qb, NT = MLA ? 4 * (qb + 1) : 4;
    const int skey = tid >> 3, sch = tid & 7, skey2 = (tid >> 2) & 63, sch2 = 8 + (tid & 3);
    const unsigned kgo = (unsigned)(((rowbase + skey) * A.pk + sch * 8) * 2), kgo2 = (unsigned)(((rowbase + skey2) * A.pk + sch2 * 8) * 2), vgo = (unsigned)(((rowbase + skey) * A.pv + sch * 8) * 2);
    const char* Kbp = (const char*)A.K; const char* Vbp = (const char*)A.V; const unsigned kts = 128u * A.pk, vts = 128u * A.pv;
    const int kw = skey * 256 + ((sch ^ (skey & 15)) << 4), kw2 = skey2 * 256 + ((sch2 ^ (skey2 & 15)) << 4), vw = v_st64(skey, sch * 8);
    u32x4 skA, sk2A, svA, skB, sk2B, svB;
#define LD_K(S_, t) do { sk##S_ = *(const u32x4*)(Kbp + (kgo + (unsigned)(t) * kts)); if (DQK == 96 && tid < 256) sk2##S_ = *(const u32x4*)(Kbp + (kgo2 + (unsigned)(t) * kts)); } while (0)
#define LD_V(S_, t) do { sv##S_ = *(const u32x4*)(Vbp + (vgo + (unsigned)(t) * vts)); } while (0)
#define WR_K(S_, bf) do { *(LAS u32x4*)(lds + AT_K + (bf) * 16384 + kw) = sk##S_; if (DQK == 96 && tid < 256) *(LAS u32x4*)(lds + AT_K + (bf) * 16384 + kw2) = sk2##S_; } while (0)
#define WR_V(S_, bf) do { *(LAS u32x4*)(lds + AT_V + (bf) * 8192 + vw) = sv##S_; } while (0)
    float l_reg = 0.f; f32x16 o[2]; o[0] = f32x16{}; o[1] = f32x16{};
    const LAS unsigned char* vrd = lds + AT_V + v_rd_base(lane);
    const unsigned vra = (unsigned)(uintptr_t)vrd;
    const int lastrow = q0 + wid * 32 + 31, firstrow = q0 + wid * 32;
#define ACT(t) (64 * (T0 + (t)) <= lastrow)
#define QK(P0, P1, cur) do { P0 = f32x16{}; P1 = f32x16{}; \
        const LAS unsigned char* kt = lds + AT_K + (cur) * 16384 + r32 * 256; \
        _Pragma("unroll") \
        for (int d0 = 0; d0 < NQF; ++d0) { \
            const int off = ((2 * d0 + hi) ^ (r32 & 15)) << 4; \
            const h8 k0 = *(const LAS h8*)(kt + off), k1 = *(const LAS h8*)(kt + off + 8192); \
            P0 = __builtin_amdgcn_mfma_f32_32x32x16_f16(k0, qr[d0], P0, 0, 0, 0); \
            P1 = __builtin_amdgcn_mfma_f32_32x32x16_f16(k1, qr[d0], P1, 0, 0, 0); \
        } } while (0)
#define SOFTPV(P0, P1, t, cur) do { \
        const int kb = 64 * (T0 + (t)); \
        if (kb + 63 > firstrow) {                             \
            const int dq = qrow - kb - 4 * hi; \
            _Pragma("unroll") \
            for (int r = 0; r < 16; ++r) { const int c = (r & 3) + 8 * (r >> 2); if (c > dq) P0[r] = -INFINITY; if (c + 32 > dq) P1[r] = -INFINITY; } \
        } \
          \
        float ps = 0.f; \
        _Pragma("unroll") \
        for (int r = 0; r < 16; ++r) { P0[r] = __builtin_amdgcn_exp2f(P0[r]); P1[r] = __builtin_amdgcn_exp2f(P1[r]); ps += P0[r] + P1[r]; } \
        l_reg += ps; \
        s16x8 pa0, pa1, pa2, pa3; pack_pb(P0, P1, pa0, pa1, pa2, pa3); \
        const LAS unsigned char* vb = vrd + (cur) * 8192; \
        _Pragma("unroll") \
        for (int d0 = 0; d0 < 2; ++d0) { \
            const s16x4 l0 = vtr(vb + d0 * 512), h0 = vtr(vb + d0 * 512 + 1024), l1 = vtr(vb + d0 * 512 + 2048), h1 = vtr(vb + d0 * 512 + 3072); \
            const s16x4 l2 = vtr(vb + d0 * 512 + 4096), h2_ = vtr(vb + d0 * 512 + 5120), l3 = vtr(vb + d0 * 512 + 6144), h3 = vtr(vb + d0 * 512 + 7168); \
            o[d0] = __builtin_amdgcn_mfma_f32_32x32x16_bf16(pa0, mk8s(l0, h0), o[d0], 0, 0, 0); \
            o[d0] = __builtin_amdgcn_mfma_f32_32x32x16_bf16(pa1, mk8s(l1, h1), o[d0], 0, 0, 0); \
            o[d0] = __builtin_amdgcn_mfma_f32_32x32x16_bf16(pa2, mk8s(l2, h2_), o[d0], 0, 0, 0); \
            o[d0] = __builtin_amdgcn_mfma_f32_32x32x16_bf16(pa3, mk8s(l3, h3), o[d0], 0, 0, 0); \
        } } while (0)
#define SBAR_() __builtin_amdgcn_sched_barrier(0)
#define MASKT(PX0, PX1, t) do { const int dq = qrow - 64 * (T0 + (t)) - 4 * hi;        \
        _Pragma("unroll") \
        for (int r = 0; r < 16; ++r) { const int c = (r & 3) + 8 * (r >> 2); if (c > dq) PX0[r] = -INFINITY; if (c + 32 > dq) PX1[r] = -INFINITY; } } while (0)
#define TRA(dst, a_, off_) asm volatile("ds_read_b64_tr_b16 %0, %1 offset:%2" : "=&v"(dst) : "v"(a_), "i"(off_) : "memory")
#define VRD8A(dst, vaddr, d0_) do { TRA(dst[0], vaddr, (d0_) * 512); TRA(dst[1], vaddr, (d0_) * 512 + 1024); TRA(dst[2], vaddr, (d0_) * 512 + 2048); TRA(dst[3], vaddr, (d0_) * 512 + 3072); \
        TRA(dst[4], vaddr, (d0_) * 512 + 4096); TRA(dst[5], vaddr, (d0_) * 512 + 5120); TRA(dst[6], vaddr, (d0_) * 512 + 6144); TRA(dst[7], vaddr, (d0_) * 512 + 7168); } while (0)
#define LGKM0() do { asm volatile("s_waitcnt lgkmcnt(0)" ::: "memory"); SBAR_(); } while (0)
#define VRD8(dst, vb_, d0_) do { dst[0] = vtr((vb_) + (d0_) * 512); dst[1] = vtr((vb_) + (d0_) * 512 + 1024); dst[2] = vtr((vb_) + (d0_) * 512 + 2048); dst[3] = vtr((vb_) + (d0_) * 512 + 3072); \
        dst[4] = vtr((vb_) + (d0_) * 512 + 4096); dst[5] = vtr((vb_) + (d0_) * 512 + 5120); dst[6] = vtr((vb_) + (d0_) * 512 + 6144); dst[7] = vtr((vb_) + (d0_) * 512 + 7168); } while (0)
#define PV4(acc, vf) do { acc = __builtin_amdgcn_mfma_f32_32x32x16_bf16(pa0, mk8s(vf[0], vf[1]), acc, 0, 0, 0); acc = __builtin_amdgcn_mfma_f32_32x32x16_bf16(pa1, mk8s(vf[2], vf[3]), acc, 0, 0, 0); \
        acc = __builtin_amdgcn_mfma_f32_32x32x16_bf16(pa2, mk8s(vf[4], vf[5]), acc, 0, 0, 0); acc = __builtin_amdgcn_mfma_f32_32x32x16_bf16(pa3, mk8s(vf[6], vf[7]), acc, 0, 0, 0); } while (0)
#define MKPA(W, B_, OUT) do { auto r0_ = __builtin_amdgcn_permlane32_swap(W[B_], W[B_ + 2], false, false); auto r1_ = __builtin_amdgcn_permlane32_swap(W[B_ + 1], W[B_ + 3], false, false); \
        u32x4 w_ = {r0_[0], r1_[0], r0_[1], r1_[1]}; OUT = __builtin_bit_cast(s16x8, w_); } while (0)
#define PVT(W0, W1, VS, VF0) do { \
        s16x8 pa0, pa1, pa2, pa3; MKPA(W0, 0, pa0); MKPA(W0, 4, pa1); MKPA(W1, 0, pa2); MKPA(W1, 4, pa3); \
        const unsigned va2 = vra + (VS) * 8192; s16x4 vf1[8]; \
        SBAR_(); \
        LGKM0();                                     \
        VRD8A(vf1, va2, 1); \
        PV4(o[0], VF0); \
        SBAR_(); \
        LGKM0(); \
        PV4(o[1], vf1); \
        SBAR_(); } while (0)
#define FUSED(PX0, PX1, PY0, PY1, t, KS, VS, MASK) do { \
        if (DRY == 1) break; \
        if (DRY == 2) { const LAS unsigned char* kt = lds + AT_K + (KS) * 16384 + r32 * 256; const LAS unsigned char* vb1 = vrd + (VS) * 8192; \
            _Pragma("unroll") for (int d0 = 0; d0 < NQF; ++d0) { const int off = ((2 * d0 + hi) ^ (r32 & 15)) << 4; h8 a_ = *(const LAS h8*)(kt + off), b_ = *(const LAS h8*)(kt + off + 8192); asm volatile("" :: "v"(a_), "v"(b_)); } \
            s16x4 vfa[8], vfb[8]; VRD8(vfa, vb1, 0); VRD8(vfb, vb1, 1); _Pragma("unroll") for (int i_ = 0; i_ < 8; ++i_) asm volatile("" :: "v"(vfa[i_]), "v"(vfb[i_])); break; } \
        if (MASK) MASKT(PX0, PX1, t); \
        float ps = 0.f; unsigned wp0[8], wp1[8]; \
        const LAS unsigned char* kt = lds + AT_K + (KS) * 16384 + r32 * 256; \
        const unsigned va1 = vra + (VS) * 8192; \
        h8 kf[2][2]; s16x4 vf0[8]; \
        { const int off = ((0 + hi) ^ (r32 & 15)) << 4; kf[0][0] = *(const LAS h8*)(kt + off); kf[0][1] = *(const LAS h8*)(kt + off + 8192); } \
        SBAR_(); \
        _Pragma("unroll") \
        for (int d0 = 0; d0 < NQF; ++d0) { \
            if (d0 + 1 < NQF) { const int off = ((2 * (d0 + 1) + hi) ^ (r32 & 15)) << 4; kf[(d0 + 1) & 1][0] = *(const LAS h8*)(kt + off); kf[(d0 + 1) & 1][1] = *(const LAS h8*)(kt + off + 8192); } \
            if (d0 == 0) { PY0 = __builtin_amdgcn_mfma_f32_32x32x16_f16(kf[0][0], qr[0], f32x16{}, 0, 0, 0); PY1 = __builtin_amdgcn_mfma_f32_32x32x16_f16(kf[0][1], qr[0], f32x16{}, 0, 0, 0); } \
            else { PY0 = __builtin_amdgcn_mfma_f32_32x32x16_f16(kf[d0 & 1][0], qr[d0], PY0, 0, 0, 0); PY1 = __builtin_amdgcn_mfma_f32_32x32x16_f16(kf[d0 & 1][1], qr[d0], PY1, 0, 0, 0); } \
            if (d0 + 1 == NQF) { SBAR_(); VRD8A(vf0, va1, 0); }            \
            _Pragma("unroll") \
            for (int i = 0; i < 8; ++i) if (i >= (8 * d0) / NQF && i < (8 * (d0 + 1)) / NQF) { \
                const float e0 = __builtin_amdgcn_exp2f(PX0[2 * i]), e1 = __builtin_amdgcn_exp2f(PX0[2 * i + 1]), e2 = __builtin_amdgcn_exp2f(PX1[2 * i]), e3 = __builtin_amdgcn_exp2f(PX1[2 * i + 1]); \
                ps += (e0 + e1) + (e2 + e3); wp0[i] = pkb(e0, e1); wp1[i] = pkb(e2, e3); } \
            SBAR_(); \
        } \
        l_reg += ps; \
        PVT(wp0, wp1, VS, vf0); } while (0)
#define LASTT(PX0, PX1, t, VS) do { if (DRY) break; MASKT(PX0, PX1, t); float ps = 0.f; unsigned wp0[8], wp1[8]; s16x4 vf0[8]; VRD8A(vf0, vra + (VS) * 8192, 0); \
        _Pragma("unroll") \
        for (int i = 0; i < 8; ++i) { const float e0 = __builtin_amdgcn_exp2f(PX0[2 * i]), e1 = __builtin_amdgcn_exp2f(PX0[2 * i + 1]), e2 = __builtin_amdgcn_exp2f(PX1[2 * i]), e3 = __builtin_amdgcn_exp2f(PX1[2 * i + 1]); \
            ps += (e0 + e1) + (e2 + e3); wp0[i] = pkb(e0, e1); wp1[i] = pkb(e2, e3); } \
        l_reg += ps; PVT(wp0, wp1, VS, vf0); } while (0)
    if constexpr (!MLA) {
        LD_K(A, T0); LD_V(A, T0); WR_K(A, 0); WR_V(A, 0); __syncthreads();
#pragma unroll
        for (int t = 0; t < 4; ++t) {
            if (t + 1 < 4) { LD_K(B, T0 + t + 1); LD_V(B, T0 + t + 1); }
            if (wid >= 2 * t) {
                f32x16 p0, p1; QK(p0, p1, t & 1);
                LASTT(p0, p1, t, t & 1);
            }
            if (t + 1 < 4) { WR_K(B, (t + 1) & 1); WR_V(B, (t + 1) & 1); }
            __syncthreads();
        }
    } else {
    f32x16 pA0, pA1, pB0, pB1;
    unsigned kdo0, kdo1, vdo;
#define DMA_OFFS(ln) do { const int key0 = 8 * wid + ((ln) >> 4), key1 = key0 + 4; int c0 = ((ln) & 15) ^ (key0 & 15), c1 = ((ln) & 15) ^ (key1 & 15); if (c0 >= 12) c0 = 0; if (c1 >= 12) c1 = 0;     \
      kdo0 = (unsigned)(((rowbase + key0) * A.pk + 8 * c0) * 2); kdo1 = (unsigned)(((rowbase + key1) * A.pk + 8 * c1) * 2); \
      const int kk = 8 * wid + (((ln) & 31) >> 2), vkey = (kk & ~0xC) | ((kk & 4) << 1) | ((kk & 8) >> 1); \
      vdo = (unsigned)(((rowbase + vkey) * A.pv + 32 * ((ln) >> 5) + 8 * ((ln) & 3)) * 2); } while (0)
    DMA_OFFS(lane);
#define GLDS(src, dstoff) __builtin_amdgcn_global_load_lds((const unsigned*)(src), (LAS unsigned*)(lds + (dstoff)), 16, 0, 0)
#define DMA_K(t) do { const int sl_ = ((t) & 3) * 16384 + wid * 2048; GLDS(Kbp + (kdo0 + (unsigned)(t) * kts), AT_K + sl_); GLDS(Kbp + (kdo1 + (unsigned)(t) * kts), AT_K + sl_ + 1024); } while (0)
#define DMA_V(t) do { GLDS(Vbp + (vdo + (unsigned)(t) * vts), AT_V + ((t) & 3) * 8192 + wid * 1024); } while (0)
#define WAITBAR(N) do { asm volatile("s_waitcnt vmcnt(" #N ") lgkmcnt(0)" ::: "memory"); __builtin_amdgcn_s_barrier(); asm volatile("" ::: "memory"); } while (0)
    DMA_K(0); DMA_V(0); DMA_K(1); DMA_V(1); DMA_K(2);
    WAITBAR(0);
    if (!DRY) QK(pA0, pA1, 0);
    const int tb = NT - 4;
#pragma unroll 1
    for (int t = 0; t < tb; t += 2) {
        DMA_K(t + 3); DMA_V(t + 2); SBAR_();
        FUSED(pA0, pA1, pB0, pB1, t, (t + 1) & 3, t & 3, false); SBAR_();
        WAITBAR(3);
        DMA_K(t + 4); DMA_V(t + 3); SBAR_();
        FUSED(pB0, pB1, pA0, pA1, t + 1, (t + 2) & 3, (t + 1) & 3, false); SBAR_();
        WAITBAR(3);
    }
    {
    int r32_ = r32, hi_ = hi, qrow_ = qrow; asm volatile("" : "+v"(r32_), "+v"(hi_), "+v"(qrow_));
    const int r32 = r32_, hi = hi_, qrow = qrow_;
    { int ln2 = lane; asm volatile("" : "+v"(ln2)); DMA_OFFS(ln2); }
    DMA_K(tb + 3); DMA_V(tb + 2); SBAR_();
    FUSED(pA0, pA1, pB0, pB1, tb, 1, 0, true); SBAR_();
    WAITBAR(3);
    DMA_V(tb + 3); SBAR_();
    FUSED(pB0, pB1, pA0, pA1, tb + 1, 2, 1, true); SBAR_();
    WAITBAR(1);
    FUSED(pA0, pA1, pB0, pB1, tb + 2, 3, 2, true); SBAR_();
    WAITBAR(0);
    LASTT(pB0, pB1, tb + 3, 3);
    __syncthreads();
    }
#undef WAITBAR
#undef DMA_V
#undef DMA_K
#undef GLDS
#undef DMA_OFFS
    }
#undef LASTT
#undef FUSED
#undef PVT
#undef MKPA
#undef PV4
#undef VRD8
#undef LGKM0
#undef VRD8A
#undef TRA
#undef MASKT
#undef SBAR_
#undef SOFTPV
#undef QK
#undef ACT
#undef LD_K
#undef LD_V
#undef WR_K
#undef WR_V
    if (DRY) { __syncthreads(); return; }
    l_reg = swap_add(l_reg);
    if (hi == 0) wsf[32 + r32] = l_reg;
    LDS_WAIT();
    LAS float* stg = (LAS float*)(lds + AT_OST + wid * 8704);
#pragma unroll
    for (int r = 0; r < 16; ++r) { const int qq = crow(r, hi); stg[qq * 68 + r32] = o[0][r]; stg[qq * 68 + 32 + r32] = o[1][r]; }
    LDS_WAIT();
    {
        const int qq = lane >> 1, half = lane & 1; const LAS float* sp = stg + qq * 68 + 32 * half;
        f32x4 v[8]; float ss = 0.f; float ltot = wsf[32 + qq];
#pragma unroll
        for (int i = 0; i < 8; ++i) v[i] = *(const LAS f32x4*)(sp + 4 * i);
        if constexpr (!MLA) {
#pragma unroll
            for (int sl = 0; sl < 3; ++sl) { const float ls = lpre[sl];
#pragma unroll
                for (int i = 0; i < 4; ++i) { const u32x4 w = ppre[sl][i]; const f32x2 a = unpkh(w.x), bb = unpkh(w.y), c = unpkh(w.z), d = unpkh(w.w);
                    v[2 * i] += (f32x4){a[0], a[1], bb[0], bb[1]} * ls; v[2 * i + 1] += (f32x4){c[0], c[1], d[0], d[1]} * ls; }
                ltot += ls; }
        }
        const float rl = 1.0f / ltot;
#pragma unroll
        for (int i = 0; i < 8; ++i) { v[i] = v[i] * rl; ss += (v[i][0] * v[i][0] + v[i][1] * v[i][1]) + (v[i][2] * v[i][2] + v[i][3] * v[i][3]); }
        ss += __int_as_float(__builtin_amdgcn_ds_bpermute((lane ^ 1) << 2, __float_as_int(ss)));
        const float rs = __builtin_amdgcn_rsqf(ss * (1.0f / 64.0f) + EPS);
        unsigned char* dst = (unsigned char*)A.O + (rowbase + q0 + wid * 32 + qq) * DM + 32 * half;
        float mx = F8MAX; asm volatile("" : "+s"(mx));
#pragma unroll
        for (int i = 0; i < 4; i += 2) { u32x4 w;
#pragma unroll
            for (int j = 0; j < 2; ++j) { const f32x4 g0 = *(const f32x4*)(gout + 32 * half + 8 * (i + j)), g1 = *(const f32x4*)(gout + 32 * half + 8 * (i + j) + 4);
                const f32x4 a = v[2 * (i + j)] * rs * g0, c = v[2 * (i + j) + 1] * rs * g1;
                const unsigned lo = pk8c(a[0], a[1], a[2], a[3], mx), hi = pk8c(c[0], c[1], c[2], c[3], mx);
                if (j == 0) { w.x = lo; w.y = hi; } else { w.z = lo; w.w = hi; } }
            *(u32x4*)(dst + 8 * i) = w; }
    }
    LDS_WAIT();
    __syncthreads();
}

__device__ __forceinline__ void moba_select(const f16* proj, const float* ksum, unsigned* cnt, unsigned short* list, LAS unsigned char* lds, int vcu, const int tid_in) {
    int tid = tid_in; asm volatile("" : "+v"(tid));
    const int lane = tid & 63;
    const int gq = vcu * 512 + tid, bh = gq >> 13, q = gq & 8191, qb = q >> 8, b = bh >> 2, h = bh & 3;
    const int qbu = __builtin_amdgcn_readfirstlane(qb);
    const int qbmax = ((vcu * 512 + 511) & 8191) >> 8;
    LAS float* km = (LAS float*)lds;
    const float* ks = ksum + (size_t)(b * 128) * 256 + 64 * h;
    __syncthreads();
    for (int idx = tid; idx < qbmax * 64; idx += 512) { const int j = idx >> 6, d = idx & 63; const float* kp = ks + (size_t)(4 * j) * 256 + d;
        km[idx] = ((kp[0] + kp[256]) + (kp[512] + kp[768])) * (1.0f / 256.0f); }
    LDS_WAIT(); __syncthreads();
    float qf[64];
    { const f16* qp = proj + ((size_t)b * SEQ + q) * NPROJ + PC_AQ + 64 * h;
#pragma unroll
      for (int i = 0; i < 8; ++i) { const u32x4 w = *(const u32x4*)(qp + 8 * i); const f32x2 a = unpkh(w.x), bb = unpkh(w.y), c = unpkh(w.z), d = unpkh(w.w);
          qf[8 * i] = a[0]; qf[8 * i + 1] = a[1]; qf[8 * i + 2] = bb[0]; qf[8 * i + 3] = bb[1]; qf[8 * i + 4] = c[0]; qf[8 * i + 5] = c[1]; qf[8 * i + 6] = d[0]; qf[8 * i + 7] = d[1]; } }
    float v1 = -INFINITY, v2 = -INFINITY, v3 = -INFINITY; int i1 = -1, i2 = -1, i3 = -1;
    for (int j = 0; j < qbu; ++j) {
        float g = 0.f;
#pragma unroll
        for (int i = 0; i < 16; ++i) { const f32x4 kv = *(const LAS f32x4*)(km + j * 64 + 4 * i); g += qf[4 * i] * kv[0] + qf[4 * i + 1] * kv[1] + qf[4 * i + 2] * kv[2] + qf[4 * i + 3] * kv[3]; }
        if (g > v1) { v3 = v2; i3 = i2; v2 = v1; i2 = i1; v1 = g; i1 = j; }
        else if (g > v2) { v3 = v2; i3 = i2; v2 = g; i2 = j; }
        else if (g > v3) { v3 = g; i3 = j; }
    }
    unsigned mycnt = 0u; int ps1 = 0, ps2 = 0, ps3 = 0;
    for (int j = 0; j < qbu; ++j) {
        const bool mine = (i1 == j) | (i2 == j) | (i3 == j);
        const unsigned long long m = __ballot(mine);
        if (lane == j) mycnt = (unsigned)__popcll(m);
        const int pf = __popcll(m & ((1ull << lane) - 1ull));
        if (i1 == j) ps1 = pf; if (i2 == j) ps2 = pf; if (i3 == j) ps3 = pf;
    }
    unsigned base = 0u;
    if (lane < qbu && mycnt) base = atomicAdd(&cnt[bh * 32 + lane], mycnt);
    const unsigned b1 = __shfl(base, i1 < 0 ? 0 : i1), b2 = __shfl(base, i2 < 0 ? 0 : i2), b3 = __shfl(base, i3 < 0 ? 0 : i3);
    if (i1 >= 0) list[(size_t)(bh * 31 + i1) * 8192 + b1 + ps1] = (unsigned short)(q);
    if (i2 >= 0) list[(size_t)(bh * 31 + i2) * 8192 + b2 + ps2] = (unsigned short)(q | (1 << 13));
    if (i3 >= 0) list[(size_t)(bh * 31 + i3) * 8192 + b3 + ps3] = (unsigned short)(q | (2 << 13));
}

__device__ __forceinline__ void moba_sparse(const f16* proj, const unsigned* cnt, const unsigned short* list, f16* part, float* partl, LAS unsigned char* lds, int vcu, const int tid_in) {
    constexpr int SK = 0, SV = 32768, SST = 65536, SWS = 135168, SPRE = 137216;
    int tid = tid_in; asm volatile("" : "+v"(tid));
    const int lane = tid & 63, r32 = lane & 31, hi = lane >> 5; const int wid = __builtin_amdgcn_readfirstlane(tid >> 6);
    LAS int* pre = (LAS int*)(lds + SPRE); LAS int* wtot = pre + 520;
    __syncthreads();
    constexpr int SW = 8;
    int mytk = (tid < 496) ? (int)((cnt[(tid / 31) * 32 + tid % 31] + 31u) >> 5) + SW : 0;
    int inc = mytk;
#pragma unroll
    for (int o = 1; o < 64; o <<= 1) { const int u = __shfl_up(inc, o); if (lane >= o) inc += u; }
    if (lane == 63) wtot[wid] = inc;
    LDS_WAIT(); __syncthreads();
    { int off = 0; for (int w = 0; w < wid; ++w) off += wtot[w]; inc += off; }
    pre[tid + 1] = inc; if (tid == 0) pre[0] = 0;
    LDS_WAIT(); __syncthreads();
    const int W = pre[496]; const int t0 = (int)(((long)W * vcu) >> 8), t1 = (int)(((long)W * (vcu + 1)) >> 8);
    { const unsigned long long bm = __ballot(tid < 496 && inc <= t0); if (lane == 0) wtot[8 + wid] = (int)__popcll(bm); }
    LDS_WAIT(); __syncthreads();
    int ifirst = 0;
#pragma unroll
    for (int w = 0; w < 8; ++w) ifirst += wtot[8 + w];
    LAS float* wsf = (LAS float*)(lds + SWS) + wid * 64; LAS float* stg = (LAS float*)(lds + SST + wid * 8704);
    for (int i = ifirst; i < 496; ++i) {
        const int p0i = pre[i] + SW, p1i = pre[i + 1];
        if (pre[i] >= t1) break;
        const int lo = p0i > t0 ? p0i : t0, hi_ = p1i < t1 ? p1i : t1;
        if (lo >= hi_) continue;
        const int bh = i / 31, j = i - bh * 31, b = bh >> 2, h = bh & 3; const int n = (int)cnt[bh * 32 + j];
        {
            const f16* kg = proj + ((size_t)b * SEQ + 256 * j) * NPROJ + PC_AK + 64 * h; const f16* vg = proj + ((size_t)b * SEQ + 256 * j) * NPROJ + PC_AV + 64 * h;
#pragma unroll
            for (int c = 0; c < 4; ++c) { const int idx = tid + 512 * c, key = idx >> 3, ch = idx & 7;
                const u32x4 kv = *(const u32x4*)(kg + (size_t)key * NPROJ + 8 * ch), vv = *(const u32x4*)(vg + (size_t)key * NPROJ + 8 * ch);
                *(LAS u32x4*)(lds + SK + rm_off(key, ch)) = kv; *(LAS u32x4*)(lds + SV + (key >> 6) * 8192 + v_st64(key & 63, 8 * ch)) = vv; }
        }
        LDS_WAIT(); __syncthreads();
        const f16* qbase = proj + ((size_t)b * SEQ) * NPROJ + PC_AQ + 64 * h + 8 * hi;
        const int tau0 = lo - p0i + wid, tauE = hi_ - p0i;
        unsigned e_n = 0u, e_nn = 0u; h8 qn[4];
        if (tau0 < tauE) { const int ei = 32 * tau0 + r32; e_n = list[(size_t)i * 8192 + (ei < n ? ei : 32 * tau0)];
            const f16* qp = qbase + (size_t)(e_n & 8191) * NPROJ;
#pragma unroll
            for (int d0 = 0; d0 < 4; ++d0) qn[d0] = *(const h8*)(qp + 16 * d0); }
        if (tau0 + 8 < tauE) { const int ei = 32 * (tau0 + 8) + r32; e_nn = list[(size_t)i * 8192 + (ei < n ? ei : 32 * (tau0 + 8))]; }
        for (int tau = tau0; tau < tauE; tau += 8) {
            const unsigned e = e_n; h8 qr[4];
#pragma unroll
            for (int d0 = 0; d0 < 4; ++d0) qr[d0] = qn[d0];
            if (tau + 8 < tauE) { e_n = e_nn;
                const f16* qp = qbase + (size_t)(e_n & 8191) * NPROJ;
#pragma unroll
                for (int d0 = 0; d0 < 4; ++d0) qn[d0] = *(const h8*)(qp + 16 * d0);
                if (tau + 16 < tauE) { const int ei = 32 * (tau + 16) + r32; e_nn = list[(size_t)i * 8192 + (ei < n ? ei : 32 * (tau + 16))]; } }
            float l_reg = 0.f; f32x16 o[2]; o[0] = f32x16{}; o[1] = f32x16{};
#pragma unroll 1
            for (int kt = 0; kt < 4; ++kt) {
                f32x16 p0 = f32x16{}, p1 = f32x16{};
#pragma unroll
                for (int d0 = 0; d0 < 4; ++d0) {
                    const LAS unsigned char* ka = lds + SK + rm_off(64 * kt + r32, 2 * d0 + hi);
                    const h8 k0 = *(const LAS h8*)ka, k1 = *(const LAS h8*)(ka + 4096);
                    p0 = __builtin_amdgcn_mfma_f32_32x32x16_f16(k0, qr[d0], p0, 0, 0, 0);
                    p1 = __builtin_amdgcn_mfma_f32_32x32x16_f16(k1, qr[d0], p1, 0, 0, 0);
                }
                float ps = 0.f;
#pragma unroll
                for (int r = 0; r < 16; ++r) { p0[r] = __builtin_amdgcn_exp2f(p0[r]); p1[r] = __builtin_amdgcn_exp2f(p1[r]); ps += p0[r] + p1[r]; }
                l_reg += ps;
                s16x8 pa0, pa1, pa2, pa3; pack_pb(p0, p1, pa0, pa1, pa2, pa3);
                const LAS unsigned char* vb = lds + SV + kt * 8192 + v_rd_base(lane);
#pragma unroll
                for (int d0 = 0; d0 < 2; ++d0) {
                    const s16x4 l0 = vtr(vb + d0 * 512), h0 = vtr(vb + d0 * 512 + 1024), l1 = vtr(vb + d0 * 512 + 2048), h1 = vtr(vb + d0 * 512 + 3072);
                    const s16x4 l2 = vtr(vb + d0 * 512 + 4096), h2_ = vtr(vb + d0 * 512 + 5120), l3 = vtr(vb + d0 * 512 + 6144), h3 = vtr(vb + d0 * 512 + 7168);
                    o[d0] = __builtin_amdgcn_mfma_f32_32x32x16_bf16(pa0, mk8s(l0, h0), o[d0], 0, 0, 0);
                    o[d0] = __builtin_amdgcn_mfma_f32_32x32x16_bf16(pa1, mk8s(l1, h1), o[d0], 0, 0, 0);
                    o[d0] = __builtin_amdgcn_mfma_f32_32x32x16_bf16(pa2, mk8s(l2, h2_), o[d0], 0, 0, 0);
                    o[d0] = __builtin_amdgcn_mfma_f32_32x32x16_bf16(pa3, mk8s(l3, h3), o[d0], 0, 0, 0);
                }
            }
            l_reg = swap_add(l_reg);
            if (hi == 0) { wsf[r32] = l_reg; wsf[32 + r32] = __uint_as_float(e); }
#pragma unroll
            for (int r = 0; r < 16; ++r) { const int qq = crow(r, hi); stg[qq * 68 + r32] = o[0][r]; stg[qq * 68 + 32 + r32] = o[1][r]; }
            LDS_WAIT();
            {
                const int qq = lane >> 1, half = lane & 1; const LAS float* sp = stg + qq * 68 + 32 * half;
                const float lq = wsf[qq]; const unsigned eq = __float_as_uint(wsf[32 + qq]); const float rl = 1.0f / lq;
                if (32 * tau + qq < n) {
                    const size_t pi = (size_t)((eq >> 13) * 16 + bh) * 8192 + (eq & 8191);
                    f16* dst = part + pi * 64 + 32 * half;
#pragma unroll
                    for (int ii = 0; ii < 4; ++ii) { const f32x4 a = *(const LAS f32x4*)(sp + 8 * ii) * rl, c = *(const LAS f32x4*)(sp + 8 * ii + 4) * rl;
                        u32x4 w; w.x = pkh(a[0], a[1]); w.y = pkh(a[2], a[3]); w.z = pkh(c[0], c[1]); w.w = pkh(c[2], c[3]); *(u32x4*)(dst + 8 * ii) = w; }
                    if (half == 0) partl[pi] = lq;
                }
            }
            LDS_WAIT();
        }
        __syncthreads();
    }
}

constexpr int ML_ITEM = 65536;
constexpr int ML_Q = 0, ML_K = 8192, ML_V = 16384, ML_C = 32768, ML_F = 49152;
constexpr int MLF_GS = 0, MLF_BT = 64, MLF_W = 128, MLF_N = 192, MLF_SC = 256;
__device__ __forceinline__ float log_sigmoid(float x) { return fminf(x, 0.f) - log1pf(__expf(-fabsf(x))); }
__device__ __forceinline__ float silu(float y) { return y * __builtin_amdgcn_rcpf(1.0f + __expf(-y)); }

constexpr int ML_CW = 139264;
__device__ __forceinline__ void ml_load_conv(LAS unsigned char* lds, const float* cw, const float* cb, const float* gmo, int tid) {
    LAS float* d = (LAS float*)(lds + ML_CW);
    for (int i = tid; i < 3072; i += 512) d[i] = (i < 2048) ? cw[i] : (i < 2560 ? cb[i - 2048] : gmo[i - 2560]);
    LDS_WAIT(); __syncthreads();
}
template <int NCH>
__device__ __forceinline__ void conv_silu_seq(const f16* proj, LAS const float* cw, LAS const float* cb, size_t grow, int tseq, int col0, float scale, float (&y)[NCH]) {
#pragma unroll
    for (int c = 0; c < NCH; c += 4) { const f32x4 bv = *(LAS const f32x4*)(cb + col0 + c); y[c] = bv[0]; y[c + 1] = bv[1]; y[c + 2] = bv[2]; y[c + 3] = bv[3]; }
#pragma unroll
    for (int j = 0; j < 4; ++j) {
        if (tseq - 3 + j >= 0) {
            const f16* src = proj + (grow - 3 + j) * NPROJ + col0;
#pragma unroll
            for (int q = 0; q < NCH / 8; ++q) { const u32x4 w = *(const u32x4*)(src + 8 * q); const f32x4 w0 = *(LAS const f32x4*)(cw + j * 512 + col0 + 8 * q), w1 = *(LAS const f32x4*)(cw + j * 512 + col0 + 8 * q + 4);
                const f32x2 a = unpkh(w.x), b = unpkh(w.y), c = unpkh(w.z), d = unpkh(w.w);
                y[8 * q + 0] += a[0] * w0[0]; y[8 * q + 1] += a[1] * w0[1]; y[8 * q + 2] += b[0] * w0[2]; y[8 * q + 3] += b[1] * w0[3];
                y[8 * q + 4] += c[0] * w1[0]; y[8 * q + 5] += c[1] * w1[1]; y[8 * q + 6] += d[0] * w1[2]; y[8 * q + 7] += d[1] * w1[3]; }
        }
    }
#pragma unroll
    for (int c = 0; c < NCH; ++c) y[c] = silu(y[c]) * scale;
}
template <int NCH, int TB = 4>
__device__ __forceinline__ void conv_silu(const f16* proj, LAS const float* cw, LAS const float* cb, size_t grow, int tseq, int col0, float scale, float (&y)[NCH]) {
#pragma unroll
    for (int c = 0; c < NCH; c += 4) { const f32x4 bv = *(LAS const f32x4*)(cb + col0 + c); y[c] = bv[0]; y[c + 1] = bv[1]; y[c + 2] = bv[2]; y[c + 3] = bv[3]; }
#pragma unroll
    for (int j0 = 0; j0 < 4; j0 += TB) {
        u32x4 wq_[TB][NCH / 8];
#pragma unroll
        for (int jj = 0; jj < TB; ++jj) { const int j = j0 + jj;
            const bool ok = (tseq - 3 + j >= 0);
            const f16* src = proj + (grow - (ok ? (size_t)(3 - j) : (size_t)0)) * NPROJ + col0;
#pragma unroll
            for (int q = 0; q < NCH / 8; ++q) wq_[jj][q] = *(const u32x4*)(src + 8 * q);
        }
#pragma unroll
        for (int jj = 0; jj < TB; ++jj) { const int j = j0 + jj;
            const bool ok = (tseq - 3 + j >= 0);
#pragma unroll
            for (int q = 0; q < NCH / 8; ++q) { u32x4 w = wq_[jj][q]; w.x = ok ? w.x : 0u; w.y = ok ? w.y : 0u; w.z = ok ? w.z : 0u; w.w = ok ? w.w : 0u;
                const f32x4 w0 = *(LAS const f32x4*)(cw + j * 512 + col0 + 8 * q), w1 = *(LAS const f32x4*)(cw + j * 512 + col0 + 8 * q + 4);
                const f32x2 a = unpkh(w.x), b = unpkh(w.y), c = unpkh(w.z), d = unpkh(w.w);
                y[8 * q + 0] += a[0] * w0[0]; y[8 * q + 1] += a[1] * w0[1]; y[8 * q + 2] += b[0] * w0[2]; y[8 * q + 3] += b[1] * w0[3];
                y[8 * q + 4] += c[0] * w1[0]; y[8 * q + 5] += c[1] * w1[1]; y[8 * q + 6] += d[0] * w1[2]; y[8 * q + 7] += d[1] * w1[3]; }
        }
    }
#pragma unroll
    for (int c = 0; c < NCH; ++c) y[c] = silu(y[c]) * scale;
}

struct MlArgs { float* btg; const f16* proj; const float* gates; const float* cw; const float* cb; const float* bi; const float* bf; f16* cst; float* nst; float* ba; float* mst; f16* mix; const float* gmo; };

__device__ __forceinline__ void ml_gates(const MlArgs& M, int mode, size_t grow0, int head, int bh, int j, LAS float* fl, int lane) {
    const float* gp = M.gates + (grow0 + lane) * 8;
    const float ip = gp[head] + M.bi[head], fp = gp[4 + head] + M.bf[head];
    float c = log_sigmoid(fp);
#pragma unroll
    for (int o = 1; o < 64; o <<= 1) { const float u = __shfl_up(c, o); if (lane >= o) c += u; }
    if (mode == 0) {
        const float Bt = __shfl(c, 63);
        const float lw = Bt - c + ip;
        float a = lw;
#pragma unroll
        for (int o = 1; o < 64; o <<= 1) a = fmaxf(a, __shfl_xor(a, o));
        fl[MLF_W + lane] = __expf(lw - a);
        *(f32x2*)(M.btg + ((grow0 + lane) * 4 + head) * 2) = (f32x2){c, ip - c};
        if (lane == 0) { M.ba[((size_t)bh * 128 + j) * 2] = Bt; M.ba[((size_t)bh * 128 + j) * 2 + 1] = a; }
    } else {
        fl[MLF_GS + lane] = ip - c; fl[MLF_BT + lane] = c;
    }
}

__device__ __forceinline__ void mlstm_m1(const MlArgs& M, LAS unsigned char* lds, int vcu, const int tid_in) {
    int tid = tid_in; asm volatile("" : "+v"(tid));
    const int hw = tid >> 8, th = tid & 255, lane = tid & 63, r32 = lane & 31, hi = lane >> 5; const int wq = __builtin_amdgcn_readfirstlane((tid >> 6) & 3);
    LAS unsigned char* L = lds + hw * ML_ITEM; LAS float* fl = (LAS float*)(L + ML_F);
    ml_load_conv(lds, M.cw, M.cb, M.gmo, tid);
    if (wq == 0) {
#pragma unroll
        for (int rd = 0; rd < 4; ++rd) { const int item = vcu * 8 + rd * 2 + hw, c64 = item >> 2, head = item & 3, b = c64 >> 7, j = c64 & 127;
            ml_gates(M, 0, (size_t)c64 * 64, head, b * 4 + head, j, fl + 512 + rd * 64 - MLF_W, lane); }
    }
    LDS_WAIT(); __syncthreads();
    for (int rd = 0; rd < 4; ++rd) {
        const int item = vcu * 8 + rd * 2 + hw, c64 = item >> 2, head = item & 3, b = c64 >> 7, j = c64 & 127, bh = b * 4 + head;
        const size_t grow0 = (size_t)c64 * 64;
        LAS const float* wv = fl + 512 + rd * 64;
        {
            const int s = th >> 2, part = th & 3;
            float y[16];
            conv_silu<16>(M.proj, (LAS const float*)(lds + ML_CW), (LAS const float*)(lds + ML_CW) + 2048, grow0 + s, j * 64 + s, PC_MK + 64 * head + 16 * part, 1.0f, y);
#pragma unroll
            for (int q = 0; q < 2; ++q) { u32x4 w; w.x = pkh(y[8 * q], y[8 * q + 1]); w.y = pkh(y[8 * q + 2], y[8 * q + 3]); w.z = pkh(y[8 * q + 4], y[8 * q + 5]); w.w = pkh(y[8 * q + 6], y[8 * q + 7]);
                *(LAS u32x4*)(L + ML_K + v_st64(s, 16 * part + 8 * q)) = w; }
            const float ws = wv[s];
            const f16* vp = M.proj + (grow0 + s) * NPROJ + PC_MV + 128 * head + 32 * part;
#pragma unroll
            for (int q = 0; q < 4; ++q) { const u32x4 w = *(const u32x4*)(vp + 8 * q); const f32x2 a = unpkh(w.x), bb = unpkh(w.y), c = unpkh(w.z), d = unpkh(w.w);
                u32x4 o; o.x = pkh(a[0] * ws, a[1] * ws); o.y = pkh(bb[0] * ws, bb[1] * ws); o.z = pkh(c[0] * ws, c[1] * ws); o.w = pkh(d[0] * ws, d[1] * ws);
                *(LAS u32x4*)(L + ML_V + v_st128(s, 32 * part + 8 * q)) = o; }
        }
        LDS_WAIT(); __syncthreads();
        {
            f32x16 acc[2]; acc[0] = f32x16{}; acc[1] = f32x16{};
            const LAS unsigned char* vb = L + ML_V + v_rd_base(lane) + wq * 512; const LAS unsigned char* kb = L + ML_K + v_rd_base(lane);
#pragma unroll
            for (int ks = 0; ks < 4; ++ks) {
                const h8 af = mk8(vtr(vb + ks * 4096), vtr(vb + ks * 4096 + 2048));
#pragma unroll
                for (int db = 0; db < 2; ++db) { const h8 bf_ = mk8(vtr(kb + db * 512 + ks * 2048), vtr(kb + db * 512 + ks * 2048 + 1024));
                    acc[db] = __builtin_amdgcn_mfma_f32_32x32x16_f16(bf_, af, acc[db], 0, 0, 0); }
            }
            f16* dst = M.cst + ((size_t)bh * 128 + j) * 8192 + (32 * wq + r32) * 64 + 4 * hi;
#pragma unroll
            for (int db = 0; db < 2; ++db)
#pragma unroll
                for (int g = 0; g < 4; ++g) { u32x2 w; w.x = pkh(acc[db][4 * g], acc[db][4 * g + 1]); w.y = pkh(acc[db][4 * g + 2], acc[db][4 * g + 3]); *(u32x2*)(dst + 32 * db + 8 * g) = w; }
            if (th < 64) { float s = 0.f; for (int k = 0; k < 64; ++k) s += wv[k] * (float)*(const LAS f16*)(L + ML_K + v_st64(k, th)); M.nst[((size_t)bh * 128 + j) * 64 + th] = s; }
        }
        LDS_WAIT(); __syncthreads();
    }
}

template <int STRIDE>
__device__ __forceinline__ void m2_chain(float* base, int el, const float* ba) {
    constexpr int NB = 32;
    float mp = 0.f, c = 0.f;
    float xa[NB], xb[NB];
#pragma unroll
    for (int u = 0; u < NB; ++u) xa[u] = base[u * STRIDE + el];
    for (int j0 = 0; j0 < 128; j0 += NB) {
        if (j0 + NB < 128) {
#pragma unroll
            for (int u = 0; u < NB; ++u) xb[u] = base[(j0 + NB + u) * STRIDE + el];
        }
#pragma unroll
        for (int u = 0; u < NB; ++u) {
            const float Bj = ba[2 * (j0 + u)], aj = ba[2 * (j0 + u) + 1];
            const float mn = fmaxf(Bj + mp, aj);
            const float dec = __expf(Bj + mp - mn), sc = __expf(aj - mn);
            const float xin = xa[u]; xa[u] = c;
            c = dec * c + sc * xin; mp = mn;
        }
#pragma unroll
        for (int u = 0; u < NB; ++u) base[(j0 + u) * STRIDE + el] = xa[u];
#pragma unroll
        for (int u = 0; u < NB; ++u) xa[u] = xb[u];
    }
}
__device__ __forceinline__ void m2_chain2(const unsigned* bin, unsigned* bout, int el, const float* ba, float* mst_or_null) {
    constexpr int NB = 32;
    float mp = 0.f, c0 = 0.f, c1 = 0.f;
    unsigned xa[NB], xb[NB];
#pragma unroll
    for (int u = 0; u < NB; ++u) xa[u] = bin[u * 4096 + el];
    for (int j0 = 0; j0 < 128; j0 += NB) {
        if (j0 + NB < 128) {
#pragma unroll
            for (int u = 0; u < NB; ++u) xb[u] = bin[(j0 + NB + u) * 4096 + el];
        }
#pragma unroll
        for (int u = 0; u < NB; ++u) {
            const float Bj = ba[2 * (j0 + u)], aj = ba[2 * (j0 + u) + 1];
            const float mn = fmaxf(Bj + mp, aj);
            const float dec = __expf(Bj + mp - mn), sc = __expf(aj - mn);
            const f32x2 xin = unpkh(xa[u]); xa[u] = pkh(c0, c1);
            if (mst_or_null) mst_or_null[j0 + u] = mp;
            c0 = dec * c0 + sc * xin[0]; c1 = dec * c1 + sc * xin[1]; mp = mn;
        }
#pragma unroll
        for (int u = 0; u < NB; ++u) bout[(j0 + u) * 4096 + el] = xa[u];
#pragma unroll
        for (int u = 0; u < NB; ++u) xa[u] = xb[u];
    }
}
__device__ __forceinline__ void mlstm_m2(const MlArgs& M, int vcu, int tid) {
    const int bh = vcu >> 4;
    const float* ba = M.ba + (size_t)bh * 256;
    if (tid < 256) { const int el = (vcu & 15) * 256 + tid;
        m2_chain2((const unsigned*)(M.cst + (size_t)bh * 128 * 8192), (unsigned*)(M.cst + (size_t)16 * 128 * 8192 + (size_t)bh * 128 * 8192), el, ba, el == 0 ? M.mst + bh * 128 : nullptr); }
    else if (tid < 260) { const int el = (vcu & 15) * 4 + (tid - 256);
        m2_chain<64>(M.nst + (size_t)bh * 128 * 64, el, ba); }
}

__device__ __forceinline__ void mlstm_m3(const MlArgs& M, LAS unsigned char* lds, int vcu, const int tid_in) {
    int tid = tid_in; asm volatile("" : "+v"(tid));
    const int hw = tid >> 8, th = tid & 255, lane = tid & 63, r32 = lane & 31, hi = lane >> 5; const int wq = __builtin_amdgcn_readfirstlane((tid >> 6) & 3);
    const int qh = wq & 1, vh = wq >> 1;
    LAS unsigned char* L = lds + hw * ML_ITEM; LAS float* fl = (LAS float*)(L + ML_F);
    ml_load_conv(lds, M.cw, M.cb, M.gmo, tid);
    for (int rd = 0; rd < 4; ++rd) {
        const int item = vcu * 8 + rd * 2 + hw, c64 = item >> 2, head = item & 3, b = c64 >> 7, j = c64 & 127, bh = b * 4 + head;
        const size_t grow0 = (size_t)c64 * 64;
        {
            if (th < 64) { const f32x2 bg = *(const f32x2*)(M.btg + ((grow0 + th) * 4 + head) * 2); fl[MLF_BT + th] = bg[0]; fl[MLF_GS + th] = bg[1]; }
            if (th == 64) fl[MLF_W] = M.mst[bh * 128 + j];
            const int s = th >> 2, part = th & 3;
            float y[32];
            conv_silu_seq<32>(M.proj, (LAS const float*)(lds + ML_CW), (LAS const float*)(lds + ML_CW) + 2048, grow0 + s, j * 64 + s, (part < 2 ? PC_MQ : PC_MK) + 64 * head + 32 * (part & 1), part < 2 ? 0.125f : 1.0f, y);
            LAS unsigned char* dstt = L + (part < 2 ? ML_Q : ML_K);
#pragma unroll
            for (int q = 0; q < 4; ++q) { u32x4 w; w.x = pkh(y[8 * q], y[8 * q + 1]); w.y = pkh(y[8 * q + 2], y[8 * q + 3]); w.z = pkh(y[8 * q + 4], y[8 * q + 5]); w.w = pkh(y[8 * q + 6], y[8 * q + 7]);
                *(LAS u32x4*)(dstt + rm_off(s, 4 * (part & 1) + q)) = w; }
            const f16* vp = M.proj + (grow0 + s) * NPROJ + PC_MV + 128 * head + 32 * part;
#pragma unroll
            for (int q = 0; q < 4; ++q) *(LAS u32x4*)(L + ML_V + v_st128(s, 32 * part + 8 * q)) = *(const u32x4*)(vp + 8 * q);
            const int v = th >> 1, half = th & 1;
            const f16* cp = M.cst + (size_t)16 * 128 * 8192 + ((size_t)bh * 128 + j) * 8192 + v * 64 + 32 * half;
#pragma unroll
            for (int q = 0; q < 4; ++q) *(LAS u32x4*)(L + ML_C + rm_off(v, 4 * half + q)) = *(const u32x4*)(cp + 8 * q);
            if (th < 64) fl[MLF_N + th] = M.nst[((size_t)bh * 128 + j) * 64 + th];
        }
        LDS_WAIT(); __syncthreads();
        f32x16 o[2]; o[0] = f32x16{}; o[1] = f32x16{};
        float scl;
        u32x4 ogw[4];
        { const f16* op = M.proj + (grow0 + (th >> 2)) * NPROJ + PC_MO + 128 * head + 32 * (th & 3);
#pragma unroll
          for (int i = 0; i < 4; ++i) ogw[i] = *(const u32x4*)(op + 8 * i); }
        {
            const int t = 32 * qh + r32;
            const float mprev = fl[MLF_W];
            h8 qf[4];
#pragma unroll
            for (int d0 = 0; d0 < 4; ++d0) qf[d0] = *(const LAS h8*)(L + ML_Q + rm_off(t, 2 * d0 + hi));
            f32x16 p0 = f32x16{}, p1 = f32x16{};
#pragma unroll
            for (int d0 = 0; d0 < 4; ++d0) { const h8 k0 = *(const LAS h8*)(L + ML_K + rm_off(r32, 2 * d0 + hi));
                p0 = __builtin_amdgcn_mfma_f32_32x32x16_f16(k0, qf[d0], p0, 0, 0, 0); }
            if (qh == 1) {
#pragma unroll
                for (int d0 = 0; d0 < 4; ++d0) { const h8 k1 = *(const LAS h8*)(L + ML_K + rm_off(32 + r32, 2 * d0 + hi));
                    p1 = __builtin_amdgcn_mfma_f32_32x32x16_f16(k1, qf[d0], p1, 0, 0, 0); }
            }
            const float btt = fl[MLF_BT + t];
            float ld0[16], ld1[16]; float mi = -INFINITY;
#pragma unroll
            for (int r = 0; r < 16; ++r) { const int s0 = crow(r, hi), s1 = s0 + 32;
                ld0[r] = (s0 <= t) ? btt + fl[MLF_GS + s0] : -INFINITY; ld1[r] = (s1 <= t) ? btt + fl[MLF_GS + s1] : -INFINITY;
                mi = fmaxf(mi, fmaxf(ld0[r], ld1[r])); }
            mi = swap_max(mi);
            const float linter = btt + mprev, mt = fmaxf(linter, mi), inter = __expf(linter - mt);
            float rs = 0.f;
#pragma unroll
            for (int r = 0; r < 16; ++r) { p0[r] *= __expf(ld0[r] - mt); p1[r] *= __expf(ld1[r] - mt); rs += p0[r] + p1[r]; }
            rs = swap_add(rs);
            float qn = 0.f;
#pragma unroll
            for (int d0 = 0; d0 < 4; ++d0)
#pragma unroll
                for (int jj = 0; jj < 8; ++jj) qn += (float)qf[d0][jj] * fl[MLF_N + 16 * d0 + 8 * hi + jj];
            qn = swap_add(qn);
            const float den = rs + inter * qn;
            scl = __builtin_amdgcn_rcpf(fmaxf(fabsf(den), __expf(-mt)));
            h8 pa0, pa1, pa2, pa3; pack_p(p0, p1, pa0, pa1, pa2, pa3);
            h8 qa[4];
#pragma unroll
            for (int d0 = 0; d0 < 4; ++d0) { u32x4 w; w.x = pkh((float)qf[d0][0] * inter, (float)qf[d0][1] * inter); w.y = pkh((float)qf[d0][2] * inter, (float)qf[d0][3] * inter);
                w.z = pkh((float)qf[d0][4] * inter, (float)qf[d0][5] * inter); w.w = pkh((float)qf[d0][6] * inter, (float)qf[d0][7] * inter); qa[d0] = __builtin_bit_cast(h8, w); }
            const LAS unsigned char* vb = L + ML_V + v_rd_base(lane);
#pragma unroll
            for (int vbk = 0; vbk < 2; ++vbk) {
                const int cb = 2 * vh + vbk;
#pragma unroll
                for (int d0 = 0; d0 < 4; ++d0) { const h8 cf = *(const LAS h8*)(L + ML_C + rm_off(32 * cb + r32, 2 * d0 + hi));
                    o[vbk] = __builtin_amdgcn_mfma_f32_32x32x16_f16(qa[d0], cf, o[vbk], 0, 0, 0); }
                const LAS unsigned char* vc = vb + cb * 512;
                o[vbk] = __builtin_amdgcn_mfma_f32_32x32x16_f16(pa0, mk8(vtr(vc), vtr(vc + 2048)), o[vbk], 0, 0, 0);
                o[vbk] = __builtin_amdgcn_mfma_f32_32x32x16_f16(pa1, mk8(vtr(vc + 4096), vtr(vc + 6144)), o[vbk], 0, 0, 0);
                o[vbk] = __builtin_amdgcn_mfma_f32_32x32x16_f16(pa2, mk8(vtr(vc + 8192), vtr(vc + 10240)), o[vbk], 0, 0, 0);
                o[vbk] = __builtin_amdgcn_mfma_f32_32x32x16_f16(pa3, mk8(vtr(vc + 12288), vtr(vc + 14336)), o[vbk], 0, 0, 0);
            }
            if (hi == 0) fl[MLF_SC + wq * 64 + r32] = scl;
        }
        LDS_WAIT(); __syncthreads();
        {
            LAS float* stg = (LAS float*)L;
#pragma unroll
            for (int r = 0; r < 16; ++r) { const int tl = crow(r, hi); const float sc = fl[MLF_SC + wq * 64 + tl]; const int t = 32 * qh + tl;
                stg[t * 132 + 32 * (2 * vh) + r32] = o[0][r] * sc; stg[t * 132 + 32 * (2 * vh + 1) + r32] = o[1][r] * sc; }
        }
        LDS_WAIT(); __syncthreads();
        {
            const int t = th >> 2, part = th & 3; const LAS float* sp = (const LAS float*)L + t * 132 + 32 * part;
            f32x4 v[8]; float ss = 0.f;
#pragma unroll
            for (int i = 0; i < 8; ++i) { v[i] = *(const LAS f32x4*)(sp + 4 * i); ss += (v[i][0] * v[i][0] + v[i][1] * v[i][1]) + (v[i][2] * v[i][2] + v[i][3] * v[i][3]); }
            ss += __shfl_xor(ss, 1); ss += __shfl_xor(ss, 2);
            const float rsn = __builtin_amdgcn_rsqf(ss * (1.0f / 128.0f) + EPS);
            LAS const float* gp = (LAS const float*)(lds + ML_CW) + 2560 + 128 * head + 32 * part;
            unsigned char* dst = (unsigned char*)M.mix + (grow0 + t) * DM + 128 * head + 32 * part;
            u32x4 w8;
#pragma unroll
            for (int i = 0; i < 4; ++i) { const u32x4 ow = ogw[i]; const f32x2 a = unpkh(ow.x), bb = unpkh(ow.y), c = unpkh(ow.z), d = unpkh(ow.w);
                const f32x4 g0 = *(LAS const f32x4*)(gp + 8 * i), g1 = *(LAS const f32x4*)(gp + 8 * i + 4);
                const float og[8] = {a[0], a[1], bb[0], bb[1], c[0], c[1], d[0], d[1]};
                float r8[8];
#pragma unroll
                for (int e = 0; e < 4; ++e) { r8[e] = v[2 * i][e] * rsn * g0[e] * __builtin_amdgcn_rcpf(1.0f + __expf(-og[e])); r8[4 + e] = v[2 * i + 1][e] * rsn * g1[e] * __builtin_amdgcn_rcpf(1.0f + __expf(-og[4 + e])); }
                const unsigned lo = pk8(r8[0], r8[1], r8[2], r8[3]), hi = pk8(r8[4], r8[5], r8[6], r8[7]);
                if ((i & 1) == 0) { w8.x = lo; w8.y = hi; } else { w8.z = lo; w8.w = hi; *(u32x4*)(dst + 8 * (i - 1)) = w8; } }
        }
        LDS_WAIT(); __syncthreads();
    }
}

__device__ __forceinline__ void mla_kprep(f16* proj, f16* lkv, const float* gk, const float* cosd, const float* sind, int gw, int ngw, int lane) {
    const int head = lane >> 4, jl = lane & 15;
    const f32x4 g = *(const f32x4*)(gk + 4 * jl); const float g1 = gk[64 + jl], g2 = gk[80 + jl];
    constexpr int R = 4;
    for (int row0 = gw * R; row0 < T; row0 += ngw * R) {
        u32x2 nw[R]; float k1[R], k2[R], c[R], sn[R];
#pragma unroll
        for (int r = 0; r < R; ++r) { const size_t row = (size_t)(row0 + r);
            nw[r] = *(const u32x2*)(lkv + row * LQP + 128 * head + 4 * jl);
            k1[r] = (float)proj[row * NPROJ + PC_KPE + jl]; k2[r] = (float)proj[row * NPROJ + PC_KPE + 16 + jl];
            c[r] = cosd[row * 16 + jl]; sn[r] = sind[row * 16 + jl]; }
#pragma unroll
        for (int r = 0; r < R; ++r) { const size_t row = (size_t)(row0 + r);
            const f32x2 n0 = unpkh(nw[r].x), n1 = unpkh(nw[r].y);
            float ss = n0[0] * n0[0] + n0[1] * n0[1] + n1[0] * n1[0] + n1[1] * n1[1] + k1[r] * k1[r] + k2[r] * k2[r];
            ss += __shfl_xor(ss, 1); ss += __shfl_xor(ss, 2); ss += __shfl_xor(ss, 4); ss += __shfl_xor(ss, 8);
            const float rs = __builtin_amdgcn_rsqf(ss * (1.0f / 96.0f) + EPS);
            u32x2 w; w.x = pkh(n0[0] * rs * g[0], n0[1] * rs * g[1]); w.y = pkh(n1[0] * rs * g[2], n1[1] * rs * g[3]);
            f16* dst = proj + row * NPROJ + PC_LK + 96 * head;
            *(u32x2*)(dst + 4 * jl) = w;
            const float x1 = k1[r] * rs * g1, x2 = k2[r] * rs * g2;
            dst[64 + jl] = (f16)(x1 * c[r] - x2 * sn[r]); dst[80 + jl] = (f16)(x2 * c[r] + x1 * sn[r]); }
    }
}

constexpr int NPHASE = 1 + 7 * DEPTH;

__global__ void __launch_bounds__(512, 2) hybrid_fwd(Params p) {
    extern __shared__ __attribute__((aligned(16))) unsigned char lds_raw[];
    LAS unsigned char* lds = (LAS unsigned char*)lds_raw;
    volatile LAS unsigned* MISC = (volatile LAS unsigned*)(lds + MISC_OFF);
    const int wave0 = __builtin_amdgcn_readfirstlane((int)threadIdx.x >> 6);
    for (int u = threadIdx.x; u < (LDS_BYTES - MISC_OFF) / 4; u += 512) ((LAS unsigned*)(lds + MISC_OFF))[u] = 0u;
    __syncthreads();
    if (!MK_PER_PHASE) (void)xcd_barrier_post((unsigned*)(p.ws + WS_CTL) + 4096, MISC + 8);
#define GRID_BAR() do { if (!MK_PER_PHASE) { XcdBarrier bar_; bar_.bar = (unsigned*)(ws + WS_CTL) + 4096; bar_.x = xb_xcc_id(); bar_.st = (volatile LAS unsigned*)(lds + MISC_OFF) + 8; xcd_barrier(bar_); } } while (0)

    if (p.ph_lo == 0) { const int ph = 0;
        int G = gridDim.x, bx = blockIdx.x; asm volatile("" : "+s"(G), "+s"(bx));
        const int vcu = (G % 8 == 0) ? (bx % 8) * (G / 8) + bx / 8 : bx;
        unsigned long long wsi = (unsigned long long)p.ws; asm volatile("" : "+s"(wsi));
        unsigned char* ws = (unsigned char*)(GAS unsigned char*)wsi;
#define TIDNOW() ({ int t_; asm volatile("v_mbcnt_lo_u32_b32 %0, -1, 0\n\tv_mbcnt_hi_u32_b32 %0, -1, %0" : "=v"(t_)); t_ + wave0 * 64; })
#define LANENOW() (TIDNOW() & 63)
        const int wave = wave0;
#define ssqa ((float*)(ws + WS_SM + SM_SSQA))
#define ssqb ((float*)(ws + WS_SM + SM_SSQB))
#define cqp ((float*)(ws + WS_SM + SM_CQP))
#define ckvp ((float*)(ws + WS_SM + SM_CKVP))
#define gates ((float*)(ws + WS_SM + SM_GATES))
#define ksum ((float*)(ws + WS_SM + SM_KSUM))
#define ba ((float*)(ws + WS_SM + SM_BA))
#define mst ((float*)(ws + WS_SM + SM_MST))
#define nst ((float*)(ws + WS_SM + SM_NST))
#define cosp ((float*)(ws + WS_SM + SM_COSP))
#define sinp ((float*)(ws + WS_SM + SM_SINP))
#define cosd ((float*)(ws + WS_SM + SM_COSD))
#define sind ((float*)(ws + WS_SM + SM_SIND))
#define x16 ((f16*)(ws + WS_X16))
#define RES_D0 ((f16*)p.out)
#define RES_D1 ((f16*)p.out + (size_t)T * DM)
#define RES_W ((f16*)(ws + WS_RESW))
#define cst ((f16*)(ws + WS_X16))
#define mix ((f16*)(ws + WS_MIX))
#define proj ((f16*)(ws + WS_PROJ))
#define lq ((f16*)(ws + WS_LQ))
#define lkv ((f16*)(ws + WS_LKV))
#define hb ((f16*)(ws + WS_H))
#define part ((f16*)(ws + WS_PART))
#define partl ((float*)(ws + WS_PARTL))
#define list ((unsigned short*)(ws + WS_LIST))
        const int gw = vcu * 8 + wave, ngw = G * 8;
        if (ph == 0) { for (int rep0 = 0; rep0 < DBL_P0; ++rep0) {
            LAS float* scr = (LAS float*)(lds + wave * 16384);
            constexpr int I_IN = 16 * 96, I_UQ = 6 * 16, I_UKV = 4 * 16, I_OUT = 16 * 32, I_UP = 16 * 128, I_DOWN = 64 * 32, I_L = I_UQ + I_UKV + I_OUT + I_DOWN;
            unsigned* ctl = (unsigned*)(ws + WS_CTL);
            static_assert(DEPTH * DM == 2048, "one w_in row per wave of the 256 x 8 grid");
            {
                const int r = gw, l = r / DM, k = r % DM; const f32x4* wr_ = (const f32x4*)(p.in[2] + ((size_t)l * DM + k) * DIN); float m = 0.f; f32x4 v[12];
#pragma unroll
                for (int i = 0; i < 12; ++i) { const int c = LANENOW() + 64 * i; v[i] = (f32x4){0.f, 0.f, 0.f, 0.f}; if (c < DIN / 4) v[i] = wr_[c]; }
#pragma unroll
                for (int i = 0; i < 12; ++i) m = fmaxf(fmaxf(m, fmaxf(fabsf(v[i][0]), fabsf(v[i][1]))), fmaxf(fabsf(v[i][2]), fabsf(v[i][3])));
                m = wave_max(m * fabsf(p.in[7][l * DM + k]));
                float m2 = 0.f; { const f32x4* ur_ = (const f32x4*)(p.in[21] + ((size_t)l * DM + k) * DFF) + LANENOW(); f32x4 u[16];
#pragma unroll
                    for (int i = 0; i < 16; ++i) u[i] = ur_[64 * i];
#pragma unroll
                    for (int i = 0; i < 16; ++i) m2 = fmaxf(fmaxf(m2, fmaxf(fabsf(u[i][0]), fabsf(u[i][1]))), fmaxf(fabsf(u[i][2]), fabsf(u[i][3]))); }
                m2 = wave_max(m2 * fabsf(p.in[20][l * DM + k]));
                LAS float* red = (LAS float*)(lds + 8 * 16384);
                if (LANENOW() == 0) { red[wave] = m; red[8 + wave] = m2; }
                LDS_WAIT(); __syncthreads();
                if (TIDNOW() == 0) { float mm = red[0], mm2 = red[8];
#pragma unroll
                    for (int i = 1; i < 8; ++i) { mm = fmaxf(mm, red[i]); mm2 = fmaxf(mm2, red[8 + i]); }
                    (void)__hip_atomic_fetch_max(ctl + CTL_WMAX + l, __float_as_uint(mm), __ATOMIC_RELAXED, __HIP_MEMORY_SCOPE_AGENT);
                    (void)__hip_atomic_fetch_max(ctl + CTL_WMAX + 2 + l, __float_as_uint(mm2), __ATOMIC_RELAXED, __HIP_MEMORY_SCOPE_AGENT);
                    (void)__hip_atomic_fetch_add(ctl + CTL_WDONE, 1u, __ATOMIC_RELEASE, __HIP_MEMORY_SCOPE_AGENT); }
            }
            if (wave < 4) {
                const int* pos = (const int*)p.in[1];
                for (int row = vcu * 4 + wave; row < T; row += G * 4) {
                    const f32x4* xr = (const f32x4*)(p.in[0] + (size_t)row * DM) + LANENOW(); f32x4 v[4]; float s = 0.f, m = 0.f;
#pragma unroll
                    for (int jx = 0; jx < 4; ++jx) { v[jx] = xr[64 * jx]; s += (v[jx][0] * v[jx][0] + v[jx][1] * v[jx][1]) + (v[jx][2] * v[jx][2] + v[jx][3] * v[jx][3]);
                        m = fmaxf(fmaxf(m, fmaxf(fabsf(v[jx][0]), fabsf(v[jx][1]))), fmaxf(fabsf(v[jx][2]), fabsf(v[jx][3]))); }
                    {
                        const int k = LANENOW(); const float ps = (float)pos[row];
                        if (k < 8) { const float f = powf(500000.0f, -(float)(2 * k) / 16.0f); float sn, cs; sincosf(ps * f, &sn, &cs); cosp[(size_t)row * 8 + k] = cs; sinp[(size_t)row * 8 + k] = sn; }
                        else if (k < 24) { const int kk = k - 8; const float f = powf(10000.0f, -(float)(2 * kk) / 32.0f); float sn, cs; sincosf(ps * f, &sn, &cs); cosd[(size_t)row * 16 + kk] = cs; sind[(size_t)row * 16 + kk] = sn; }
                    }
                    s = wave_sum(s); m = wave_max(m);
                    u32x2* o8 = (u32x2*)(RES_D1 + (size_t)row * DM) + LANENOW();
#pragma unroll
                    for (int jx = 0; jx < 4; ++jx) { u32x2 w; w.x = pkh(v[jx][0], v[jx][1]); w.y = pkh(v[jx][2], v[jx][3]); o8[64 * jx] = w; }
                    if (LANENOW() < 16) ssqa[(size_t)row * 16 + LANENOW()] = (LANENOW() == 0) ? s : 0.f;
                    const float q = m > 0.f ? 127.0f / m : 0.f;
                    unsigned* oi = (unsigned*)(ws + WS_X8I + (size_t)row * DM) + LANENOW();
#pragma unroll
                    for (int jx = 0; jx < 4; ++jx) oi[64 * jx] = pki8(v[jx][0] * q, v[jx][1] * q, v[jx][2] * q, v[jx][3] * q);
                    if (LANENOW() == 0) ((float*)(ws + WS_SM + SM_XS))[row] = m * (1.0f / 127.0f);
                }
            } else {
                const int gwb = vcu * 4 + (wave - 4), ngwb = G * 4;
                for (int it = gwb; it < DEPTH * I_L; it += ngwb) {
                    const int l = it / I_L; int r = it % I_L; unsigned char* wl = ws + WS_W + (size_t)l * W_LAYER;
                    if (r < I_UQ) { transpose_item(p.in[14] + (size_t)l * 384 * 384, 384, 384, 512, 2, p.in[12] + l * 384, (f16*)(wl + WO_UQ), scr, r, LANENOW()); continue; } r -= I_UQ;
                    if (r < I_UKV) { transpose_item(p.in[15] + (size_t)l * 256 * 512, 256, 512, 512, 0, p.in[13] + l * 256, (f16*)(wl + WO_UKV), scr, r, LANENOW()); continue; } r -= I_UKV;
                    if (r < I_OUT) { transpose_item(p.in[19] + (size_t)l * DM * DM, DM, DM, DM, 0, nullptr, (f16*)(wl + WO_OUT), scr, r, LANENOW(), F8_WOUT); continue; } r -= I_OUT;
                    transpose_item(p.in[22] + (size_t)l * DFF * DM, DFF, DM, DM, 0, nullptr, (f16*)(wl + WO_DOWN), scr, r, LANENOW(), F8_WDOWN);
                }
                if (LANENOW() == 0) { unsigned sp_ = 0; while (__hip_atomic_load(ctl + CTL_WDONE, __ATOMIC_ACQUIRE, __HIP_MEMORY_SCOPE_AGENT) < (unsigned)G) { __builtin_amdgcn_s_sleep(2); if (++sp_ > (1u << 24)) break; } }
                __builtin_amdgcn_fence(__ATOMIC_ACQUIRE, "agent");
                for (int it = gwb; it < DEPTH * I_IN; it += ngwb) {
                    const int l = it / I_IN, r = it % I_IN; unsigned char* wl = ws + WS_W + (size_t)l * W_LAYER;
                    const float wmax = __uint_as_float(__hip_atomic_load(ctl + CTL_WMAX + l, __ATOMIC_RELAXED, __HIP_MEMORY_SCOPE_AGENT));
                    transpose_item(p.in[2] + (size_t)l * DM * DIN, DM, DIN, NPROJ, 1, p.in[7] + l * DM, (f16*)(wl + WO_IN), scr, r, LANENOW(), wmax > 0.f ? 127.0f / wmax : 0.f, 1);
                    const int n0 = 32 * (r % 96);
                    if (n0 >= 1536 && n0 < 2048) transpose_item(p.in[2] + (size_t)l * DM * DIN, DM, DIN, NPROJ, 1, p.in[7] + l * DM, (f16*)(wl + WO_IN + 3 * MiB) - (size_t)1536 * DM, scr, r, LANENOW());
                }
                for (int it = gwb; it < DEPTH * I_UP; it += ngwb) {
                    const int l = it / I_UP, r = it % I_UP; unsigned char* wl = ws + WS_W + (size_t)l * W_LAYER;
                    const float wmax = __uint_as_float(__hip_atomic_load(ctl + CTL_WMAX + 2 + l, __ATOMIC_RELAXED, __HIP_MEMORY_SCOPE_AGENT));
                    transpose_item(p.in[21] + (size_t)l * DM * DFF, DM, DFF, DFF, 0, p.in[20] + l * DM, (f16*)(wl + WO_UP), scr, r, LANENOW(), wmax > 0.f ? 127.0f / wmax : 0.f, 1);
                }
            }
            }
        }
        if (1 < p.ph_hi) { for (int rep = 0; rep < DBL_BAR; ++rep) GRID_BAR(); }
    }
    for (int ph = p.ph_lo > 1 ? p.ph_lo : 1; ph < p.ph_hi; ++ph) {
        int G = gridDim.x, bx = blockIdx.x; asm volatile("" : "+s"(G), "+s"(bx));
        const int vcu = (G % 8 == 0) ? (bx % 8) * (G / 8) + bx / 8 : bx;
        unsigned long long wsi = (unsigned long long)p.ws; asm volatile("" : "+s"(wsi));
        unsigned char* ws = (unsigned char*)(GAS unsigned char*)wsi;
        const int wave = wave0;
        const int gw = vcu * 8 + wave, ngw = G * 8;
        {
            const int l = (ph - 1) / 7, sub = (ph - 1) % 7; unsigned char* wl = ws + WS_W + (size_t)l * W_LAYER;
            MlArgs ML{(float*)(ws + WS_SM + SM_BTG), proj, gates, p.in[3] + (size_t)l * 4 * 512, p.in[4] + l * 512, p.in[5] + l * 4, p.in[6] + l * 4, cst, nst, ba, mst, mix, p.in[8] + l * 512};
            if (sub == 0) {
                EpiProj E{proj, (LAS const float*)(lds + ROWSC_OFF), cqp, ckvp, gates, ksum, cosp, sinp, p.in[9] + l * 64, p.in[10] + l * 64};
                for (int rep = 0; rep < DBL_P1; ++rep) for (int pass = 0; pass < 2; ++pass) {
                if ((pass ^ ((bx >> 3) & 1)) == 0)
                {
                    pg8::StaticOrder S; S.init(T, NPROJ - 512, G, bx, 0, 6);
                    pg8::Gemm g{(const f16*)(ws + WS_X8I), (const f16*)(wl + WO_IN), T, NPROJ - 512, DM / 2, DM / 2, DM / 2};
                    rowscale_table(lds, S, ssqa, 4, 1.0f / DM, TIDNOW(), (const float*)(ws + WS_SM + SM_XS), __uint_as_float(((const unsigned*)(ws + WS_CTL))[CTL_WMAX + l]) * (1.0f / 127.0f));
                    pg8::gemm_phase<EpiProj, true, 2>(lds, g, S, E, TIDNOW()); }
                else
                {
                    pg8::StaticOrder S; S.init(T, 512, G, bx, 6);
                    pg8::Gemm g{RES_D1, (const f16*)(wl + WO_IN + 3 * MiB) - (size_t)6 * 256 * DM, T, 512, DM, DM, DM};
                    rowscale_table(lds, S, ssqa, 4, 1.0f / DM, TIDNOW());
                    pg8::gemm_phase<EpiProj, true>(lds, g, S, E, TIDNOW()); }
                }
            } else if (sub == 1) {
                for (int rep = 0; rep < DBL_P2G; ++rep) {
                { pg8::Gemm g{proj + PC_CQ, (const f16*)(wl + WO_UQ), T, 512, 384, NPROJ, 384}; pg8::StaticOrder S; S.init(T, 512, G, bx);
                  rowscale_table(lds, S, cqp, 2, 1.0f / 384.0f, TIDNOW());
                  EpiScale<0> E{lq, LQP, (LAS const float*)(lds + ROWSC_OFF), 0}; pg8::gemm_phase<EpiScale<0>, true>(lds, g, S, E, TIDNOW()); }
                { pg8::Gemm g{proj + PC_CKV, (const f16*)(wl + WO_UKV), T, 512, 256, NPROJ, 256}; pg8::StaticOrder S; S.init(T, 512, G, bx);
                  rowscale_table(lds, S, ckvp, 1, 1.0f / 256.0f, TIDNOW());
                  EpiScale<0> E{lkv, LQP, (LAS const float*)(lds + ROWSC_OFF), 1}; pg8::gemm_phase<EpiScale<0>, true>(lds, g, S, E, TIDNOW()); } }
                __syncthreads();
                for (int rep = 0; rep < DBL_P2; ++rep) mlstm_m1(ML, lds, vcu, TIDNOW());
                moba_select(proj, ksum, (unsigned*)(ws + WS_CTL) + CTL_CNT + l * 512, list, lds, vcu, TIDNOW());
            } else if (sub == 2) {
                for (int rep = 0; rep < DBL_KP; ++rep) mla_kprep(proj, lkv, p.in[17] + l * 96, cosd, sind, gw, ngw, LANENOW());
                mlstm_m2(ML, vcu, TIDNOW());
                for (int rep = 0; rep < DBL_MOBA; ++rep) moba_sparse(proj, (const unsigned*)(ws + WS_CTL) + CTL_CNT + l * 512, list, part, partl, lds, vcu, TIDNOW());
            } else if (sub == 3) {
                const int bh = vcu >> 4, s = vcu & 15, b = bh >> 2, h = bh & 3;
#ifdef PROBE_DRY
                { AttnDesc A{lq + 128 * h, proj + PC_LK + 96 * h, lkv + 128 * h + 64, LQP, NPROJ, LQP, (f16*)((unsigned char*)mix + 768 + 64 * h)};
                attn_unit<96, true, PROBE_DRY>(A, b, 31 - s, lds, p.in[16] + l * 96, cosd, sind, nullptr, nullptr, bh, p.in[18] + l * 256 + 64 * h, TIDNOW());
                attn_unit<96, true, PROBE_DRY>(A, b, s, lds, p.in[16] + l * 96, cosd, sind, nullptr, nullptr, bh, p.in[18] + l * 256 + 64 * h, TIDNOW()); }
#endif
                for (int rep = 0; rep < DBL_MLA; ++rep) {
                AttnDesc A{lq + 128 * h, proj + PC_LK + 96 * h, lkv + 128 * h + 64, LQP, NPROJ, LQP, (f16*)((unsigned char*)mix + 768 + 64 * h)};
                attn_unit<96, true>(A, b, s, lds, p.in[16] + l * 96, cosd, sind, nullptr, nullptr, bh, p.in[18] + l * 256 + 64 * h, TIDNOW());
                attn_unit<96, true>(A, b, 31 - s, lds, p.in[16] + l * 96, cosd, sind, nullptr, nullptr, bh, p.in[18] + l * 256 + 64 * h, TIDNOW()); }
                for (int rep = 0; rep < DBL_OWN; ++rep) {
                AttnDesc A{proj + PC_AQ + 64 * h, proj + PC_AK + 64 * h, proj + PC_AV + 64 * h, NPROJ, NPROJ, NPROJ, (f16*)((unsigned char*)mix + 512 + 64 * h)};
                attn_unit<64, false>(A, b, 2 * s, lds, nullptr, nullptr, nullptr, part, partl, bh, p.in[11] + l * 256 + 64 * h, TIDNOW());
                attn_unit<64, false>(A, b, 2 * s + 1, lds, nullptr, nullptr, nullptr, part, partl, bh, p.in[11] + l * 256 + 64 * h, TIDNOW());
                }
                for (int rep = 0; rep < DBL_M3; ++rep) mlstm_m3(ML, lds, vcu, TIDNOW());
            } else if (sub == 4) {
                pg8::Gemm g{mix, (const f16*)(wl + WO_OUT), T, DM, DM / 2, DM / 2, DM / 2}; pg8::StaticOrder S; S.init(T, DM, G, bx);
                rowscale_table(lds, S, ssqa, 4, 1.0f / DM, TIDNOW());
                EpiRes E{nullptr, RES_D1, nullptr, nullptr, ssqb, 1, 1.0f / F8_WOUT, (unsigned char*)x16, (float*)(ws + WS_SM + SM_XS2), (LAS const float*)(lds + ROWSC_OFF), nullptr, nullptr};
                pg8::gemm_phase<EpiRes, true, true>(lds, g, S, E, TIDNOW());
            } else if (sub == 5) {
                pg8::Gemm g{x16, (const f16*)(wl + WO_UP), T, DFF, DM / 2, DM / 2, DM / 2}; pg8::StaticOrder S; S.init(T, DFF, G, bx); S.wgm = 4;
                rowscale_table(lds, S, ssqb, 4, 1.0f / DM, TIDNOW(), (const float*)(ws + WS_SM + SM_XS2), __uint_as_float(((const unsigned*)(ws + WS_CTL))[CTL_WMAX + 2 + l]) * (1.0f / 127.0f));
                EpiAct8 E{(unsigned char*)hb, DFF, (LAS const float*)(lds + ROWSC_OFF)};
                for (int rep = 0; rep < DBL_P6; ++rep) pg8::gemm_phase<EpiAct8, true, 2>(lds, g, S, E, TIDNOW());
            } else {
                pg8::Gemm g{hb, (const f16*)(wl + WO_DOWN), T, DM, DFF / 2, DFF / 2, DFF / 2}; pg8::StaticOrder S; S.init(T, DM, G, bx);
                if (l + 1 < DEPTH) rowscale_table(lds, S, ssqb, 4, 1.0f / DM, TIDNOW());
                EpiRes E{nullptr, nullptr, l + 1 < DEPTH ? nullptr : p.out, l + 1 < DEPTH ? RES_D1 : nullptr, ssqa, l + 1 < DEPTH ? 1 : 0, 1.0f / (F8_H * F8_WDOWN), l + 1 < DEPTH ? ws + WS_X8I : nullptr, (float*)(ws + WS_SM + SM_XS), (LAS const float*)(lds + ROWSC_OFF),
                         (const unsigned char*)x16, (const float*)(ws + WS_SM + SM_XS2)};
                pg8::gemm_phase<EpiRes, true, true>(lds, g, S, E, TIDNOW());
            }
        }
        if (ph + 1 < p.ph_hi) { for (int rep = 0; rep < DBL_BAR; ++rep) GRID_BAR(); }
    }
}

extern "C" void kernel_launch(void* const* d_in, const int* in_sizes, int n_in, void* d_out, int out_size, void* d_ws, size_t ws_size, hipStream_t stream) {
    static int grid = 0;
    if (grid == 0) {
        if (n_in != 23 || in_sizes[0] != T * DM || out_size != T * DM || ws_size < WS_END) { fprintf(stderr, "kernel_launch: shape / workspace mismatch (n_in %d, ws %zu)\n", n_in, ws_size); grid = -1; return; }
        int dev = 0, cus = 0;
        if (hipGetDevice(&dev) != hipSuccess || hipDeviceGetAttribute(&cus, hipDeviceAttributeMultiprocessorCount, dev) != hipSuccess) { grid = -1; return; }
        if (hipFuncSetAttribute((const void*)hybrid_fwd, hipFuncAttributeMaxDynamicSharedMemorySize, LDS_BYTES) != hipSuccess) { fprintf(stderr, "kernel_launch: hipFuncSetAttribute failed\n"); grid = -1; return; }
        int per_cu = 0;
        if (hipOccupancyMaxActiveBlocksPerMultiprocessor(&per_cu, (const void*)hybrid_fwd, 512, LDS_BYTES) != hipSuccess || per_cu < 1) { fprintf(stderr, "kernel_launch: occupancy query reports %d\n", per_cu); }
        (void)hipGetLastError();
        grid = cus;
        if (grid != 256) { fprintf(stderr, "kernel_launch: built for 256 CUs, found %d\n", grid); grid = -1; return; }
    }
    if (grid < 0) return;
    (void)hipMemsetAsync((char*)d_ws + WS_CTL, 0, CTL_ZERO_BYTES, stream);
    Params p{};
    for (int i = 0; i < 23; ++i) p.in[i] = (const float*)d_in[i];
    p.out = (float*)d_out; p.ws = (unsigned char*)d_ws;
#if MK_PER_PHASE
    for (int ph = 0; ph < NPHASE; ++ph) { p.ph_lo = ph; p.ph_hi = ph + 1; hipLaunchKernelGGL(hybrid_fwd, dim3(grid), dim3(512), LDS_BYTES, stream, p); }
#else
    p.ph_lo = 0; p.ph_hi = NPHASE;
    hipLaunchKernelGGL(hybrid_fwd, dim3(grid), dim3(512), LDS_BYTES, stream, p);
#endif
}
```
